# Optimizing an MI355X kernel written in HIP

```python
import jax
import jax.numpy as jnp
from jax import lax
import numpy as np

D_MODEL = 2048
BATCH = 4
SEQ = 8192
DEPTH = 2

GRID_W = 64
CTX_LEN = 256
HEAD_DIM = 128
MIX_WIDTH = D_MODEL
NA_WIDTH = MIX_WIDTH // 4
POOL_WIDTH = MIX_WIDTH // 4
WA_WIDTH = MIX_WIDTH - NA_WIDTH - POOL_WIDTH
NA_HEADS = NA_WIDTH // HEAD_DIM
NA_WIN_H = 8
NA_WIN_W = 16
POOL_WINDOWS = (2, 4, 8, 16)
POOL_GROUPS = len(POOL_WINDOWS)
POOL_GROUP_DIM = POOL_WIDTH // POOL_GROUPS
WA_Q_HEADS = WA_WIDTH // HEAD_DIM
WA_KV_HEADS = WA_Q_HEADS // 4
WA_KV_WIDTH = WA_KV_HEADS * HEAD_DIM
WA_WINDOW = 128
WA_BLOCK = 128
IN_WIDTH = 3 * NA_WIDTH + POOL_WIDTH + WA_WIDTH + 2 * WA_KV_WIDTH
D_FF = 256 * ((8 * D_MODEL // 3 + 255) // 256)
N_MOD = 9
MACARON_WEIGHT = 0.5
ROPE_BASE = 10000.0
ROPE_AXIS_DIM = HEAD_DIM // 2
RMS_EPS = 1e-6
NEG_INF = -1e30

kernel_name = 'hymba_style_na_pool_wgqa_macaron_dit'


def rms_norm(x, g):
    xf = x.astype(jnp.float32)
    y = xf * lax.rsqrt(jnp.mean(jnp.square(xf), axis=-1, keepdims=True) + RMS_EPS)
    return (y * g.astype(jnp.float32)).astype(x.dtype)


def heads(t, n):
    return t.reshape(t.shape[0], t.shape[1], n, HEAD_DIM)


def half_ffn(x, shift, scale, gate, norm_g, wi, wo):
    h = rms_norm(x, norm_g) * (1 + scale) + shift
    a, b = jnp.split(h @ wi, 2, axis=-1)
    return x + MACARON_WEIGHT * gate * ((jax.nn.silu(a) * b) @ wo)


def split_projection(p):
    sizes = [NA_WIDTH, NA_WIDTH, NA_WIDTH, POOL_WIDTH, WA_WIDTH, WA_KV_WIDTH, WA_KV_WIDTH]
    offsets = [int(o) for o in np.cumsum(sizes)[:-1]]
    return jnp.split(p, offsets, axis=-1)


def axial_rope_tables(n):
    t = jnp.arange(n, dtype=jnp.int32)
    row = (t // GRID_W).astype(jnp.float32)
    col = (t % GRID_W).astype(jnp.float32)
    inv_freq = ROPE_BASE ** (-jnp.arange(0, ROPE_AXIS_DIM, 2, dtype=jnp.float32) / ROPE_AXIS_DIM)
    ang_r = row[:, None] * inv_freq[None, :]
    ang_c = col[:, None] * inv_freq[None, :]
    return (jnp.cos(ang_r), jnp.sin(ang_r), jnp.cos(ang_c), jnp.sin(ang_c))


def rotate(x, cos, sin):
    x1, x2 = jnp.split(x, 2, axis=-1)
    cos = cos[None, :, None, :]
    sin = sin[None, :, None, :]
    return jnp.concatenate([x1 * cos - x2 * sin, x2 * cos + x1 * sin], axis=-1)


def apply_axial_rope(x, tables):
    cos_r, sin_r, cos_c, sin_c = tables
    xr, xc = jnp.split(x.astype(jnp.float32), 2, axis=-1)
    return jnp.concatenate([rotate(xr, cos_r, sin_r), rotate(xc, cos_c, sin_c)], axis=-1).astype(x.dtype)


def context_attention(q, k, v, sink):
    B, C, Hq, d = q.shape
    Hk = k.shape[2]
    G = Hq // Hk
    qg = q.reshape(B, C, Hk, G, d)
    s = jnp.einsum('bqkgd,bckd->bkgqc', qg, k, preferred_element_type=jnp.float32) * (HEAD_DIM ** -0.5)
    if sink is not None:
        s_sink = jnp.broadcast_to(sink.astype(jnp.float32).reshape(1, Hk, G, 1, 1), s.shape[:-1] + (1,))
        s = jnp.concatenate([s, s_sink], axis=-1)
    p = jax.nn.softmax(s, axis=-1)[..., :C].astype(v.dtype)
    return jnp.einsum('bkgqc,bckd->bqkgd', p, v).reshape(B, C, Hq * d)


def neighbourhood_attention(q, k, v, kc, vc, rpb):
    B, S, H, d = q.shape
    rows = S // GRID_W
    kh = min(NA_WIN_H, rows)
    kw = NA_WIN_W
    qg = q.reshape(B, rows, GRID_W, H, d)
    kg = k.reshape(B, rows, GRID_W, H, d)
    vg = v.reshape(B, rows, GRID_W, H, d)
    col = jnp.arange(GRID_W)
    c0 = jnp.clip(col - kw // 2, 0, GRID_W - kw)
    col_idx = c0[:, None] + jnp.arange(kw)[None, :]
    col_off = col_idx - col[:, None] + (NA_WIN_W - 1)
    rpb_f = rpb.astype(jnp.float32)
    scale = HEAD_DIM ** -0.5
    n_nb = kh * kw

    def one_row(r):
        r0 = jnp.clip(r - kh // 2, 0, rows - kh)
        q_r = lax.dynamic_index_in_dim(qg, r, axis=1, keepdims=False)
        k_rows = lax.dynamic_slice_in_dim(kg, r0, kh, axis=1)
        v_rows = lax.dynamic_slice_in_dim(vg, r0, kh, axis=1)
        k_nb = k_rows[:, :, col_idx]
        v_nb = v_rows[:, :, col_idx]
        row_off = r0 + jnp.arange(kh) - r + (NA_WIN_H - 1)
        bias = jnp.take(rpb_f, row_off, axis=1)[:, :, col_off]
        bias = jnp.transpose(bias, (0, 2, 1, 3))
        s_nb = jnp.einsum('bqhd,biqjhd->bhqij', q_r, k_nb, preferred_element_type=jnp.float32) * scale + bias[None]
        s_ctx = jnp.einsum('bqhd,bchd->bhqc', q_r, kc, preferred_element_type=jnp.float32) * scale
        s = jnp.concatenate([s_nb.reshape(B, H, GRID_W, n_nb), s_ctx], axis=-1)
        p = jax.nn.softmax(s, axis=-1).astype(v.dtype)
        p_nb = p[..., :n_nb].reshape(B, H, GRID_W, kh, kw)
        p_ctx = p[..., n_nb:]
        return jnp.einsum('bhqij,biqjhd->bqhd', p_nb, v_nb) + jnp.einsum('bhqc,bchd->bqhd', p_ctx, vc)

    out = lax.map(one_row, jnp.arange(rows))
    return jnp.moveaxis(out, 0, 1).reshape(B, S, H * d)


def window_attention(q, k, v, kc, vc, sink):
    B, S, Hq, d = q.shape
    Hk = k.shape[2]
    G = Hq // Hk
    C = kc.shape[1]
    nblk = S // WA_BLOCK
    nloc = 3 * WA_BLOCK
    qb = q.reshape(B, nblk, WA_BLOCK, Hk, G, d)

    def band(t):
        tp = jnp.pad(t, ((0, 0), (WA_BLOCK, WA_BLOCK), (0, 0), (0, 0))).reshape(B, nblk + 2, WA_BLOCK, Hk, d)
        return jnp.concatenate([tp[:, :-2], tp[:, 1:-1], tp[:, 2:]], axis=2)

    kb = band(k)
    vb = band(v)
    j = jnp.arange(nloc)
    p_idx = jnp.arange(WA_BLOCK)
    n_idx = jnp.arange(nblk)
    in_window = jnp.abs(j[None, :] - WA_BLOCK - p_idx[:, None]) <= WA_WINDOW
    key_pos = n_idx[:, None] * WA_BLOCK + j[None, :] - WA_BLOCK
    in_seq = (key_pos >= 0) & (key_pos < S)
    mask = in_window[None, :, :] & in_seq[:, None, :]
    scale = HEAD_DIM ** -0.5
    s_loc = jnp.einsum('bnqkgd,bnskd->bkgnqs', qb, kb, preferred_element_type=jnp.float32) * scale
    s_loc = jnp.where(mask, s_loc, NEG_INF)
    s_ctx = jnp.einsum('bnqkgd,bckd->bkgnqc', qb, kc, preferred_element_type=jnp.float32) * scale
    s_sink = jnp.broadcast_to(sink.astype(jnp.float32).reshape(1, Hk, G, 1, 1, 1), s_loc.shape[:-1] + (1,))
    prob = jax.nn.softmax(jnp.concatenate([s_loc, s_ctx, s_sink], axis=-1), axis=-1).astype(v.dtype)
    out = (jnp.einsum('bkgnqs,bnskd->bnqkgd', prob[..., :nloc], vb)
           + jnp.einsum('bkgnqc,bckd->bnqkgd', prob[..., nloc:nloc + C], vc))
    return out.reshape(B, S, Hq * d)


def multiscale_pool(u, w, scale):
    B, L, C = u.shape
    uf = u.astype(jnp.float32)
    csum = jnp.concatenate([jnp.zeros((B, 1, C), jnp.float32), jnp.cumsum(uf, axis=1)], axis=1)
    t = jnp.arange(L)
    parts = []
    for g, win in enumerate(POOL_WINDOWS):
        lo = jnp.maximum(t - win // 2, 0)
        hi = jnp.minimum(t + win - win // 2 - 1, L - 1)
        sl = slice(g * POOL_GROUP_DIM, (g + 1) * POOL_GROUP_DIM)
        cg = csum[:, :, sl]
        mean = (cg[:, hi + 1] - cg[:, lo]) / (hi - lo + 1).astype(jnp.float32)[None, :, None]
        parts.append(mean - uf[:, :, sl])
    dlt = jnp.stack(parts, axis=2).astype(u.dtype)
    y = jnp.einsum('blgc,gce->blge', dlt, w) * scale.reshape(POOL_GROUPS, POOL_GROUP_DIM)
    return y.reshape(B, L, C)


def setup_inputs(seed: int = 0) -> dict:
    key = jax.random.key(seed)
    ks = jax.random.split(key, 19)
    nrm = jax.random.normal
    L, D, F = DEPTH, D_MODEL, D_FF
    return {
        'x': nrm(ks[0], (BATCH, SEQ, D), jnp.float32),
        'c': nrm(ks[1], (BATCH, D), jnp.float32),
        'ctx': nrm(ks[2], (BATCH, CTX_LEN, D), jnp.float32),
        'c_ctx': nrm(ks[3], (D,), jnp.float32),
        'w_mod': nrm(ks[4], (L, D, N_MOD * D), jnp.float32) * (0.5 * D ** -0.5),
        'b_mod': nrm(ks[5], (L, N_MOD * D), jnp.float32) * 0.01,
        'norm_w': 1.0 + 0.02 * nrm(ks[6], (L, 3, D), jnp.float32),
        'ffn1_wi': nrm(ks[7], (L, D, 2 * F), jnp.float32) * D ** -0.5,
        'ffn1_wo': nrm(ks[8], (L, F, D), jnp.float32) * F ** -0.5,
        'ffn2_wi': nrm(ks[9], (L, D, 2 * F), jnp.float32) * D ** -0.5,
        'ffn2_wo': nrm(ks[10], (L, F, D), jnp.float32) * F ** -0.5,
        'w_in': nrm(ks[11], (L, D, IN_WIDTH), jnp.float32) * D ** -0.5,
        'w_out': nrm(ks[12], (L, MIX_WIDTH, D), jnp.float32) * MIX_WIDTH ** -0.5,
        'na_qk_gain': 1.0 + 0.02 * nrm(ks[13], (L, 2, HEAD_DIM), jnp.float32),
        'na_rpb': 0.02 * nrm(ks[14], (L, NA_HEADS, 2 * NA_WIN_H - 1, 2 * NA_WIN_W - 1), jnp.float32),
        'pool_w': nrm(ks[15], (L, POOL_GROUPS, POOL_GROUP_DIM, POOL_GROUP_DIM), jnp.float32) * POOL_GROUP_DIM ** -0.5,
        'pool_scale': 1.0 + 0.02 * nrm(ks[16], (L, POOL_WIDTH), jnp.float32),
        'wa_qk_gain': 1.0 + 0.02 * nrm(ks[17], (L, 2, HEAD_DIM), jnp.float32),
        'wa_sink': 0.5 * nrm(ks[18], (L, WA_Q_HEADS), jnp.float32),
    }


def reference(x, c, ctx, c_ctx, w_mod, b_mod, norm_w, ffn1_wi, ffn1_wo, ffn2_wi, ffn2_wo,
              w_in, w_out, na_qk_gain, na_rpb, pool_w, pool_scale, wa_qk_gain, wa_sink):
    S = x.shape[1]
    rope = axial_rope_tables(S)
    for l in range(DEPTH):
        last = l == DEPTH - 1
        mx = jnp.split((jax.nn.silu(c) @ w_mod[l] + b_mod[l])[:, None, :], N_MOD, axis=-1)
        mc = jnp.split((jax.nn.silu(c_ctx) @ w_mod[l] + b_mod[l])[None, None, :], N_MOD, axis=-1)

        x = half_ffn(x, mx[0], mx[1], mx[2], norm_w[l, 0], ffn1_wi[l], ffn1_wo[l])
        ctx = half_ffn(ctx, mc[0], mc[1], mc[2], norm_w[l, 0], ffn1_wi[l], ffn1_wo[l])

        hx = rms_norm(x, norm_w[l, 1]) * (1 + mx[4]) + mx[3]
        hc = rms_norm(ctx, norm_w[l, 1]) * (1 + mc[4]) + mc[3]
        nq, nk, nv, u, wq, wk, wv = split_projection(hx @ w_in[l])
        cnq, cnk, cnv, cu, cwq, cwk, cwv = split_projection(hc @ w_in[l])

        na_kc = rms_norm(heads(cnk, NA_HEADS), na_qk_gain[l, 1])
        na_vc = heads(cnv, NA_HEADS)
        wa_kc = rms_norm(heads(cwk, WA_KV_HEADS), wa_qk_gain[l, 1])
        wa_vc = heads(cwv, WA_KV_HEADS)

        a_out = neighbourhood_attention(rms_norm(heads(nq, NA_HEADS), na_qk_gain[l, 0]),
                                        rms_norm(heads(nk, NA_HEADS), na_qk_gain[l, 1]),
                                        heads(nv, NA_HEADS), na_kc, na_vc, na_rpb[l])
        b_out = multiscale_pool(u, pool_w[l], pool_scale[l])
        q_wa = apply_axial_rope(rms_norm(heads(wq, WA_Q_HEADS), wa_qk_gain[l, 0]), rope)
        k_wa = apply_axial_rope(rms_norm(heads(wk, WA_KV_HEADS), wa_qk_gain[l, 1]), rope)
        c_out = window_attention(q_wa, k_wa, heads(wv, WA_KV_HEADS), wa_kc, wa_vc, wa_sink[l])
        x = x + mx[5] * (jnp.concatenate([a_out, b_out, c_out], axis=-1) @ w_out[l])

        if not last:
            ca = context_attention(rms_norm(heads(cnq, NA_HEADS), na_qk_gain[l, 0]), na_kc, na_vc, None)
            cb = multiscale_pool(cu, pool_w[l], pool_scale[l])
            cc = context_attention(rms_norm(heads(cwq, WA_Q_HEADS), wa_qk_gain[l, 0]), wa_kc, wa_vc, wa_sink[l])
            ctx = ctx + mc[5] * (jnp.concatenate([ca, cb, cc], axis=-1) @ w_out[l])
            ctx = half_ffn(ctx, mc[6], mc[7], mc[8], norm_w[l, 2], ffn2_wi[l], ffn2_wo[l])

        x = half_ffn(x, mx[6], mx[7], mx[8], norm_w[l, 2], ffn2_wi[l], ffn2_wo[l])
    return x
```

```cpp
#include <hip/hip_runtime.h>
#include <cstdio>
#include <cstdint>

#ifndef DBG_MASK
#define DBG_MASK 0xFFF
#endif
#ifndef DUPMASK
#define DUPMASK 0
#endif
#ifndef ATT_PIPE2
#define ATT_PIPE2 1
#endif
#ifndef LAYER_UNROLL
#define LAYER_UNROLL 2
#endif
#ifndef MK_SINGLE
#define MK_SINGLE 1
#endif

#define GAS __attribute__((address_space(1)))
#define LAS __attribute__((address_space(3)))
typedef unsigned short bf16_t;
typedef short bf16x8 __attribute__((ext_vector_type(8)));
typedef short s16x4 __attribute__((ext_vector_type(4)));
typedef float f32x4 __attribute__((ext_vector_type(4)));
typedef float f32x16 __attribute__((ext_vector_type(16)));
typedef unsigned u32x4 __attribute__((ext_vector_type(4)));
typedef unsigned u32x2 __attribute__((ext_vector_type(2)));

constexpr int DM = 2048, NBATCH = 4, SEQ = 8192, NCTX = 256, DFF = 5632, INW = 3584, DEPTH = 2, MODW = 9 * DM;
constexpr int ML = NBATCH * SEQ, MC = NBATCH * NCTX, MT = ML + MC;
constexpr float LOG2E = 1.4426950408889634f;
constexpr float QSCALE = 0.088388347648318440f * LOG2E;
constexpr int PC_NQ = 0, PC_NK = 512, PC_NV = 1024, PC_U = 1536, PC_WQ = 2048, PC_WK = 3072, PC_WV = 3328;

constexpr size_t MiB = 1u << 20;
constexpr size_t WS_CTL = 0, CTL_ZERO_BYTES = 1 * MiB;
constexpr size_t WS_MOD = 256 * 1024;
constexpr size_t WS_ROPE = 1 * MiB;
constexpr size_t WS_W = 2 * MiB;
constexpr size_t W_WI1 = 0, W_WO1 = 44 * MiB, W_WIN = 66 * MiB, W_WOUT = 80 * MiB, W_WI2 = 88 * MiB, W_WO2 = 132 * MiB, W_LAYER = 154 * MiB;
constexpr size_t WS_XC = WS_W + 2 * W_LAYER;
constexpr size_t WS_H = WS_XC + 8 * MiB;
constexpr size_t WS_HID = WS_H + 132 * MiB;
constexpr size_t WS_P = WS_HID;
constexpr size_t WS_MIX = WS_HID + 231 * MiB;
constexpr size_t WS_END = WS_HID + 363 * MiB;
static_assert((size_t)MT * DFF * 2 == 363 * MiB && (size_t)MT * INW * 2 == 231 * MiB && (size_t)MT * DM * 2 == 132 * MiB, "ws map");
static_assert(WS_MOD + (size_t)DEPTH * 5 * MODW * 4 <= CTL_ZERO_BYTES, "MOD inside the zeroed region");
constexpr int CW_BAR = 4096;

constexpr int LDS_BYTES = 147456;
constexpr int LDSCTL_OFF = LDS_BYTES - 512;

__device__ __forceinline__ unsigned f2bf(float f) { unsigned u = __builtin_bit_cast(unsigned, f); return (u + 0x7fffu + ((u >> 16) & 1u)) >> 16; }
__device__ __forceinline__ unsigned cvt_pk_bf16(float lo, float hi) { unsigned r; asm volatile("v_cvt_pk_bf16_f32 %0, %1, %2" : "=v"(r) : "v"(lo), "v"(hi)); return r; }
__device__ __forceinline__ float bf2f(unsigned short b) { return __builtin_bit_cast(float, (unsigned)b << 16); }
__device__ __forceinline__ float wave_sum(float v) {
#pragma unroll
    for (int o = 1; o < 64; o <<= 1) v += __shfl_xor(v, o);
    return v;
}
#define LDS_WAIT() asm volatile("s_waitcnt lgkmcnt(0)" ::: "memory")
#define VM_WAIT() asm volatile("s_waitcnt vmcnt(0)" ::: "memory")

namespace pg8 {
constexpr int BM = 256, BK = 64, HALF = 128, HTB = HALF * BK * 2, STAGE_BYTES = 8 * HTB, NXCD = 8, WGM = 8;
__host__ __device__ __forceinline__ int lds_byte(int r, int c) { const int st = (r >> 4) * 2 + (c >> 5), rr = r & 15, cc = c & 31, ob = rr * 64 + cc * 2; return st * 1024 + (ob ^ (((ob >> 9) & 1) << 5)); }
__host__ __device__ __forceinline__ void stage_rc(int b, int& R, int& C) { const int st = b / 1024, sb = b % 1024, swz = sb ^ (((sb >> 9) & 1) << 5); R = (st >> 1) * 16 + swz / 64; C = (st & 1) * 32 + (swz % 64) / 2; }
__host__ __device__ __forceinline__ int perm32(int rho) { const int n = rho >> 4, i = rho & 15; return 8 * (i >> 2) + 4 * n + (i & 3); }
struct Unit { int pm, pn; };
struct Gemm { const bf16_t* A; const bf16_t* Bt; int M, N, K; };
struct StaticOrder {
    int nM, nN, nwg, G, c;
    __host__ __device__ void init(int M, int N, int G_, int c_) { nM = M / BM; nN = N / BM; nwg = nM * nN; G = G_; c = c_; }
    __host__ __device__ bool next(int i, Unit& u) const {
        const long L = (long)i * G + c; if (L >= nwg) return false;
        int wgid = (int)L; { const int q = nwg / NXCD, r = nwg % NXCD, xcd = wgid % NXCD, off = wgid / NXCD; wgid = (xcd < r ? xcd * (q + 1) : r * (q + 1) + (xcd - r) * q) + off; }
        const int nig = WGM * nN, gid = wgid / nig, fm = gid * WGM, gsz = (nM - fm) < WGM ? (nM - fm) : WGM;
        u.pm = fm + ((wgid % nig) % gsz); u.pn = (wgid % nig) / gsz; return true;
    }
    __device__ __forceinline__ void a_ready(const Unit&) const {}
    __device__ __forceinline__ void done(const Unit&) const {}
};

struct EpiBf16 {
    static constexpr bool PERM = true, AFTER_DRAIN = false;
    bf16_t* O; int ldc;
    __device__ __forceinline__ void operator()(const f32x4 (&acc)[2][2][4][2], const Unit& u, int wr, int wc, int fr, int fq) const {
        const int row0 = u.pm * BM + wr * 64 + fr, col0 = u.pn * BM + wc * 32 + 8 * fq;
#pragma unroll
        for (int ai = 0; ai < 2; ++ai)
#pragma unroll
            for (int m = 0; m < 4; ++m) { bf16_t* rowp = O + (size_t)(row0 + ai * HALF + m * 16) * ldc + col0;
#pragma unroll
                for (int bj = 0; bj < 2; ++bj) { const f32x4 v0 = acc[ai][bj][m][0], v1 = acc[ai][bj][m][1];
                    u32x4 w; w.x = cvt_pk_bf16(v0[0], v0[1]); w.y = cvt_pk_bf16(v0[2], v0[3]); w.z = cvt_pk_bf16(v1[0], v1[1]); w.w = cvt_pk_bf16(v1[2], v1[3]);
                    *(u32x4*)(rowp + bj * HALF) = w; } }
    }
};
__device__ __forceinline__ float silu_mul(float a, float b) { return a * b * __builtin_amdgcn_rcpf(1.0f + __builtin_amdgcn_exp2f(-a * LOG2E)); }
struct EpiSwiglu {
    static constexpr bool PERM = true, AFTER_DRAIN = false;
    bf16_t* O;
    __device__ __forceinline__ void operator()(const f32x4 (&acc)[2][2][4][2], const Unit& u, int wr, int wc, int fr, int fq) const {
        const int row0 = u.pm * BM + wr * 64 + fr, col0 = u.pn * HALF + wc * 32 + 8 * fq;
#pragma unroll
        for (int ai = 0; ai < 2; ++ai)
#pragma unroll
            for (int m = 0; m < 4; ++m) { bf16_t* rowp = O + (size_t)(row0 + ai * HALF + m * 16) * DFF + col0;
                const f32x4 a0 = acc[ai][0][m][0], a1 = acc[ai][0][m][1], b0 = acc[ai][1][m][0], b1 = acc[ai][1][m][1];
                u32x4 w; w.x = cvt_pk_bf16(silu_mul(a0[0], b0[0]), silu_mul(a0[1], b0[1])); w.y = cvt_pk_bf16(silu_mul(a0[2], b0[2]), silu_mul(a0[3], b0[3]));
                w.z = cvt_pk_bf16(silu_mul(a1[0], b1[0]), silu_mul(a1[1], b1[1])); w.w = cvt_pk_bf16(silu_mul(a1[2], b1[2]), silu_mul(a1[3], b1[3]));
                *(u32x4*)rowp = w; }
    }
};
struct EpiResid {
    static constexpr bool PERM = false, AFTER_DRAIN = false;
    const float* xin_l; const float* xin_c; float* xout_l; float* xout_c; const float* gate; float gs;
    __device__ __forceinline__ void operator()(const f32x4 (&acc)[2][2][4][2], const Unit& u, int wr, int wc, int fr, int fq) const {
        const bool lat = u.pm < (ML / BM); const int s = lat ? (u.pm >> 5) : 4;
        const float* xi = lat ? xin_l + (size_t)u.pm * BM * DM : xin_c + (size_t)(u.pm - ML / BM) * BM * DM;
        float* xo = lat ? xout_l + (size_t)u.pm * BM * DM : xout_c + (size_t)(u.pm - ML / BM) * BM * DM;
        const int r0 = wr * 64 + fr, col0 = u.pn * BM + wc * 32 + 4 * fq;
        const float* gp = gate + (size_t)s * MODW + col0;
#pragma unroll
        for (int bj = 0; bj < 2; ++bj)
#pragma unroll
            for (int n = 0; n < 2; ++n) { const f32x4 gv = *(const f32x4*)(gp + bj * HALF + n * 16) * gs;
#pragma unroll
                for (int ai = 0; ai < 2; ++ai)
#pragma unroll
                    for (int m = 0; m < 4; ++m) { const size_t off = (size_t)(r0 + ai * HALF + m * 16) * DM + col0 + bj * HALF + n * 16;
                        const f32x4 xv = *(const f32x4*)(xi + off); *(f32x4*)(xo + off) = xv + gv * acc[ai][bj][m][n]; } }
    }
};

template <class Epi, class Sched, bool ALIGN_EPI = false, bool SP2 = false>
__device__ __forceinline__ void gemm_phase(LAS unsigned char* lds, const Gemm g, const Sched& S, const Epi& E) {
    int tid = threadIdx.x; asm volatile("" : "+v"(tid));
    const int wid = __builtin_amdgcn_readfirstlane(tid >> 6), lane = tid & 63, wr = wid >> 2, wc = wid & 3, fr = lane & 15, fq = lane >> 4;
    const int K = g.K, nt = K / BK;
    unsigned voffA[2], voffB[2];
#pragma unroll
    for (int i = 0; i < 2; ++i) { int R, C; stage_rc(tid * 16 + i * 8192, R, C); const int Rb = Epi::PERM ? ((R & ~31) + perm32(R & 31)) : R;
        voffA[i] = (unsigned)(R * K + C) * 2u; voffB[i] = (unsigned)(Rb * K + C) * 2u; }
    const size_t kstep = (size_t)(BK * 2);
    const size_t hstep = (size_t)HALF * K * 2;
    const size_t tstep = 2 * hstep;
    const unsigned ldsw = (unsigned)wid * 1024u;
    const int aoff = lds_byte(wr * 64 + fr, fq * 8), boff = lds_byte(wc * 32 + fr, fq * 8);
#define PG8_SA(b, h) (((b) * 2 + (h)) * HTB)
#define PG8_SB(b, h) ((4 + (b) * 2 + (h)) * HTB)
#define PG8_STAGE(bufoff, gbase, voff) do { _Pragma("unroll") for (int _i = 0; _i < 2; ++_i) \
        __builtin_amdgcn_global_load_lds((const unsigned*)((const char*)(gbase) + (voff)[_i]), (LAS unsigned*)(lds + (bufoff) + ldsw + _i * 8192), 16, 0, 0); } while (0)
#define PG8_LDA(dst, b, h) do { _Pragma("unroll") for (int m = 0; m < 4; ++m) _Pragma("unroll") for (int k = 0; k < 2; ++k) dst[m][k] = *(const LAS bf16x8*)(lds + PG8_SA(b, h) + aoff + m * 2048 + k * 1024); } while (0)
#define PG8_LDB(dst, b, h) do { _Pragma("unroll") for (int n = 0; n < 2; ++n) _Pragma("unroll") for (int k = 0; k < 2; ++k) dst[n][k] = *(const LAS bf16x8*)(lds + PG8_SB(b, h) + boff + n * 2048 + k * 1024); } while (0)
#define PG8_MMA(ai, bj, At, Bt) do { __builtin_amdgcn_s_setprio(1); _Pragma("unroll") for (int m = 0; m < 4; ++m) _Pragma("unroll") for (int n = 0; n < 2; ++n) _Pragma("unroll") for (int k = 0; k < 2; ++k) \
        acc[ai][bj][m][n] = __builtin_amdgcn_mfma_f32_16x16x32_bf16(Bt[n][k], At[m][k], acc[ai][bj][m][n], 0, 0, 0); __builtin_amdgcn_s_setprio(0); } while (0)
#define PG8_WAIT_V(n) asm volatile("s_waitcnt vmcnt(" #n ")" ::: "memory")
#define PG8_WAIT_L(n) asm volatile("s_waitcnt lgkmcnt(" #n ")" ::: "memory")
#define PG8_BAR __builtin_amdgcn_s_barrier()
#define PG8_SCHED __builtin_amdgcn_sched_barrier(0)
    Unit cur, nxt; int ui = 0;
    if (!S.next(0, cur)) return;
    f32x4 acc[2][2][4][2];
#pragma unroll
    for (int a = 0; a < 2; ++a)
#pragma unroll
        for (int b = 0; b < 2; ++b)
#pragma unroll
            for (int m = 0; m < 4; ++m)
#pragma unroll
                for (int n = 0; n < 2; ++n) acc[a][b][m][n] = (f32x4){0.f, 0.f, 0.f, 0.f};
    bf16x8 At[4][2], B0[2][2], B1[2][2];
    const char* cA = (const char*)g.A + (size_t)cur.pm * tstep; const char* cB = (const char*)g.Bt + (size_t)cur.pn * tstep;
    S.a_ready(cur);
    if constexpr (SP2) {
        PG8_STAGE(PG8_SB(0, 0), cB, voffB); PG8_STAGE(PG8_SB(0, 1), cB + hstep, voffB); PG8_STAGE(PG8_SA(0, 0), cA, voffA); PG8_STAGE(PG8_SA(0, 1), cA + hstep, voffA);
        if (wr == 1) PG8_BAR;
        PG8_WAIT_V(2); PG8_BAR;
        PG8_STAGE(PG8_SB(1, 0), cB + kstep, voffB); PG8_STAGE(PG8_SA(1, 0), cA + kstep, voffA); PG8_STAGE(PG8_SB(1, 1), cB + hstep + kstep, voffB);
        PG8_WAIT_V(6); PG8_BAR;
    } else {
        PG8_STAGE(PG8_SB(0, 0), cB, voffB); PG8_STAGE(PG8_SA(0, 0), cA, voffA); PG8_STAGE(PG8_SB(0, 1), cB + hstep, voffB); PG8_STAGE(PG8_SA(0, 1), cA + hstep, voffA);
        if (wr == 1) PG8_BAR;
        PG8_WAIT_V(4); PG8_BAR;
        PG8_STAGE(PG8_SB(1, 0), cB + kstep, voffB); PG8_STAGE(PG8_SA(1, 0), cA + kstep, voffA); PG8_STAGE(PG8_SB(1, 1), cB + hstep + kstep, voffB);
        PG8_WAIT_V(6); PG8_BAR;
    }
    for (;;) {
        const bool has_next = S.next(ui + 1, nxt);
        const char* nA = has_next ? (const char*)g.A + (size_t)nxt.pm * tstep : cA; const char* nB = has_next ? (const char*)g.Bt + (size_t)nxt.pn * tstep : cB;
        for (int t = 0; t < nt; t += 2) {
            const bool last = (t == nt - 2);
            const char* a1 = cA + (size_t)(t + 1) * kstep;
            const char* a2 = last ? nA : cA + (size_t)(t + 2) * kstep; const char* b2 = last ? nB : cB + (size_t)(t + 2) * kstep;
            const char* a3 = a2 + kstep; const char* b3 = b2 + kstep;
            if (last && has_next) S.a_ready(nxt);
            if constexpr (SP2) {
            PG8_LDB(B0, 0, 0); PG8_LDB(B1, 0, 1); PG8_SCHED; PG8_LDA(At, 0, 0); PG8_STAGE(PG8_SA(1, 1), a1 + hstep, voffA);
            PG8_WAIT_V(8); PG8_WAIT_L(0); PG8_BAR; PG8_MMA(0, 0, At, B0); PG8_MMA(0, 1, At, B1); PG8_BAR; PG8_SCHED;
            PG8_LDA(At, 0, 1); PG8_STAGE(PG8_SB(0, 0), b2, voffB); PG8_STAGE(PG8_SB(0, 1), b2 + hstep, voffB); PG8_STAGE(PG8_SA(0, 0), a2, voffA);
            PG8_WAIT_V(8); PG8_WAIT_L(0); PG8_BAR; PG8_MMA(1, 0, At, B0); PG8_MMA(1, 1, At, B1); PG8_BAR; PG8_SCHED;
            PG8_LDB(B0, 1, 0); PG8_LDB(B1, 1, 1); PG8_SCHED; PG8_LDA(At, 1, 0); PG8_STAGE(PG8_SA(0, 1), a2 + hstep, voffA);
            PG8_WAIT_V(8); PG8_WAIT_L(0); PG8_BAR; PG8_MMA(0, 0, At, B0); PG8_MMA(0, 1, At, B1); PG8_BAR; PG8_SCHED;
            PG8_LDA(At, 1, 1); PG8_STAGE(PG8_SB(1, 0), b3, voffB); PG8_STAGE(PG8_SB(1, 1), b3 + hstep, voffB); PG8_STAGE(PG8_SA(1, 0), a3, voffA);
            PG8_WAIT_V(8); PG8_WAIT_L(0); PG8_BAR; PG8_MMA(1, 0, At, B0); PG8_MMA(1, 1, At, B1); PG8_BAR; PG8_SCHED;
            } else {
            PG8_LDB(B0, 0, 0); PG8_SCHED; PG8_LDA(At, 0, 0); PG8_STAGE(PG8_SA(1, 1), a1 + hstep, voffA);
            PG8_WAIT_L(8); PG8_BAR; PG8_WAIT_L(0); PG8_MMA(0, 0, At, B0); PG8_BAR; PG8_SCHED;
            PG8_LDB(B1, 0, 1); PG8_STAGE(PG8_SB(0, 0), b2, voffB);
            PG8_BAR; PG8_WAIT_L(0); PG8_MMA(0, 1, At, B1); PG8_BAR;
            PG8_LDA(At, 0, 1); PG8_STAGE(PG8_SA(0, 0), a2, voffA);
            PG8_BAR; PG8_WAIT_L(0); PG8_MMA(1, 0, At, B0); PG8_BAR; PG8_SCHED;
            PG8_STAGE(PG8_SB(0, 1), b2 + hstep, voffB);
            PG8_WAIT_V(6); PG8_BAR; PG8_MMA(1, 1, At, B1); PG8_BAR;
            PG8_LDB(B0, 1, 0); PG8_SCHED; PG8_LDA(At, 1, 0); PG8_STAGE(PG8_SA(0, 1), a2 + hstep, voffA);
            PG8_WAIT_L(8); PG8_BAR; PG8_WAIT_L(0); PG8_MMA(0, 0, At, B0); PG8_BAR; PG8_SCHED;
            PG8_LDB(B1, 1, 1); PG8_STAGE(PG8_SB(1, 0), b3, voffB);
            PG8_BAR; PG8_WAIT_L(0); PG8_MMA(0, 1, At, B1); PG8_BAR;
            PG8_LDA(At, 1, 1); PG8_STAGE(PG8_SA(1, 0), a3, voffA);
            PG8_BAR; PG8_WAIT_L(0); PG8_MMA(1, 0, At, B0); PG8_BAR; PG8_SCHED;
            PG8_STAGE(PG8_SB(1, 1), b3 + hstep, voffB);
            PG8_WAIT_V(6); PG8_BAR; PG8_MMA(1, 1, At, B1); PG8_BAR;
            }
        }
        if constexpr (ALIGN_EPI) { if (wr == 0) PG8_BAR; }
        if constexpr (!Epi::AFTER_DRAIN) { E(acc, cur, wr, wc, fr, fq); S.done(cur); }
        if (!has_next) break;
#pragma unroll
        for (int a = 0; a < 2; ++a)
#pragma unroll
            for (int b = 0; b < 2; ++b)
#pragma unroll
                for (int m = 0; m < 4; ++m)
#pragma unroll
                    for (int n = 0; n < 2; ++n) acc[a][b][m][n] = (f32x4){0.f, 0.f, 0.f, 0.f};
        cur = nxt; cA = nA; cB = nB; ++ui;
        if constexpr (ALIGN_EPI) { if (wr == 1) PG8_BAR; }
    }
    PG8_WAIT_V(0);
    if constexpr (!ALIGN_EPI) { if (wr == 0) PG8_BAR; }
    PG8_BAR;
#undef PG8_SA
#undef PG8_SB
#undef PG8_STAGE
#undef PG8_LDA
#undef PG8_LDB
#undef PG8_MMA
#undef PG8_WAIT_V
#undef PG8_WAIT_L
#undef PG8_BAR
#undef PG8_SCHED
}
}

namespace att {
constexpr int SHM_V = 64 * 128 * 2, SHM_K = SHM_V;
constexpr int OFF_V = 0, OFF_K = 2 * SHM_V, OFF_WS = 4 * SHM_V, OFF_OST = OFF_WS + 2048, OST_WAVE = 32 * 272, OFF_RPB = OFF_OST + 8 * OST_WAVE, ATT_LDS_END = OFF_RPB + 2048;
static_assert(ATT_LDS_END <= LDSCTL_OFF, "attention LDS map");
constexpr float THR = 11.5f;
#define KSWZ(row, colB) ((row) * 256 + ((colB) ^ (((row) & 7) << 4)))
#define SBAR() __builtin_amdgcn_sched_barrier(0)
__device__ __forceinline__ int crow(int r, int hi) { return (r & 3) + 8 * (r >> 2) + 4 * hi; }
__device__ __forceinline__ void partialSM(f32x16& p0, f32x16& p1, float& m_reg, float& mn, float& alpha) {
    float pmax = p0[0];
#pragma unroll
    for (int r = 1; r < 16; ++r) pmax = fmaxf(pmax, p0[r]);
#pragma unroll
    for (int r = 0; r < 16; ++r) pmax = fmaxf(pmax, p1[r]);
    { auto rr = __builtin_amdgcn_permlane32_swap(__float_as_uint(pmax), __float_as_uint(pmax), false, false);
      pmax = fmaxf(__uint_as_float(rr[0]), __uint_as_float(rr[1])); }
    if (__builtin_expect(__all(pmax - m_reg <= THR), 1)) { mn = m_reg; alpha = 1.f; }
    else { mn = fmaxf(m_reg, pmax); alpha = __builtin_amdgcn_exp2f(m_reg - mn); m_reg = mn; }
#pragma unroll
    for (int r = 0; r < 16; ++r) p0[r] = p0[r] - mn;
#pragma unroll
    for (int r = 0; r < 16; ++r) p1[r] = p1[r] - mn;
#pragma unroll
    for (int r = 0; r < 16; ++r) p0[r] = __builtin_amdgcn_exp2f(p0[r]);
}
__device__ __forceinline__ void finishSM(f32x16& p0, f32x16& p1, float alpha, float& l_reg, bf16x8& pa0, bf16x8& pa1, bf16x8& pa2, bf16x8& pa3) {
#pragma unroll
    for (int r = 0; r < 16; ++r) p1[r] = __builtin_amdgcn_exp2f(p1[r]);
    float ps = 0;
#pragma unroll
    for (int r = 0; r < 16; ++r) ps += p0[r];
#pragma unroll
    for (int r = 0; r < 16; ++r) ps += p1[r];
    { auto rr = __builtin_amdgcn_permlane32_swap(__float_as_uint(ps), __float_as_uint(ps), false, false);
      ps = __uint_as_float(rr[0]) + __uint_as_float(rr[1]); }
    l_reg = l_reg * alpha + ps;
#define PK4(P, BASE, OUT) do { unsigned a0 = cvt_pk_bf16(P[BASE + 0], P[BASE + 1]), a1 = cvt_pk_bf16(P[BASE + 2], P[BASE + 3]);   \
    unsigned b0 = cvt_pk_bf16(P[BASE + 4], P[BASE + 5]), b1 = cvt_pk_bf16(P[BASE + 6], P[BASE + 7]);                              \
    auto r0 = __builtin_amdgcn_permlane32_swap(a0, b0, false, false); auto r1 = __builtin_amdgcn_permlane32_swap(a1, b1, false, false); \
    u32x4 w = {r0[0], r1[0], r0[1], r1[1]}; OUT = __builtin_bit_cast(bf16x8, w); } while (0)
    PK4(p0, 0, pa0); PK4(p0, 8, pa1); PK4(p1, 0, pa2); PK4(p1, 8, pa3);
#undef PK4
}
__device__ __forceinline__ void qkt(f32x16& p0, f32x16& p1, const LAS char* Ks, const bf16x8* qr, int r32, int hi) {
    p0 = f32x16{}; p1 = f32x16{};
#pragma unroll
    for (int d0 = 0; d0 < 8; ++d0) { const int cb = (d0 * 16 + hi * 8) * 2;
        const bf16x8 b0 = *(const LAS bf16x8*)(Ks + KSWZ(r32, cb));
        const bf16x8 b1 = *(const LAS bf16x8*)(Ks + KSWZ(32 + r32, cb));
        p0 = __builtin_amdgcn_mfma_f32_32x32x16_bf16(b0, qr[d0], p0, 0, 0, 0);
        p1 = __builtin_amdgcn_mfma_f32_32x32x16_bf16(b1, qr[d0], p1, 0, 0, 0); }
}
__device__ __forceinline__ int v_st(int k, int c) { const int kk = (k & ~0xC) | ((k & 4) << 1) | ((k & 8) >> 1); return ((kk >> 3) * 4 + (c >> 5)) * 512 + ((kk & 7) * 32 + (c & 31)) * 2; }
__device__ __forceinline__ int v_rd_base(int lane) { return ((lane & 3) << 3) | (((lane >> 2) & 3) << 6) | (((lane >> 4) & 1) << 5) | (((lane >> 5) & 1) << 8); }
constexpr int v_rd_off(int d0, int ks, int half) { return d0 * 512 + ks * 4096 + half * 2048; }
template <int OFF> __device__ __forceinline__ s16x4 tr_read(int vb) {
    s16x4 r; asm volatile("ds_read_b64_tr_b16 %0, %1 offset:%2" : "=&v"(r) : "v"(vb), "i"(OFF) : "memory"); return r;
}
template <int D0> __device__ __forceinline__ void pv_one(f32x16& od, int vb, bf16x8 pa0, bf16x8 pa1, bf16x8 pa2, bf16x8 pa3) {
    const s16x4 l0 = tr_read<v_rd_off(D0, 0, 0)>(vb), h0 = tr_read<v_rd_off(D0, 0, 1)>(vb), l1 = tr_read<v_rd_off(D0, 1, 0)>(vb), h1 = tr_read<v_rd_off(D0, 1, 1)>(vb);
    const s16x4 l2 = tr_read<v_rd_off(D0, 2, 0)>(vb), h2 = tr_read<v_rd_off(D0, 2, 1)>(vb), l3 = tr_read<v_rd_off(D0, 3, 0)>(vb), h3 = tr_read<v_rd_off(D0, 3, 1)>(vb);
    asm volatile("s_waitcnt lgkmcnt(0)" ::: "memory"); SBAR();
#define PK(L, H) (bf16x8){L[0], L[1], L[2], L[3], H[0], H[1], H[2], H[3]}
    od = __builtin_amdgcn_mfma_f32_32x32x16_bf16(pa0, PK(l0, h0), od, 0, 0, 0);
    od = __builtin_amdgcn_mfma_f32_32x32x16_bf16(pa1, PK(l1, h1), od, 0, 0, 0);
    od = __builtin_amdgcn_mfma_f32_32x32x16_bf16(pa2, PK(l2, h2), od, 0, 0, 0);
    od = __builtin_amdgcn_mfma_f32_32x32x16_bf16(pa3, PK(l3, h3), od, 0, 0, 0);
#undef PK
}
__device__ __forceinline__ void pv_d0(f32x16* o, int vb, bf16x8 pa0, bf16x8 pa1, bf16x8 pa2, bf16x8 pa3) {
    pv_one<0>(o[0], vb, pa0, pa1, pa2, pa3); pv_one<1>(o[1], vb, pa0, pa1, pa2, pa3); pv_one<2>(o[2], vb, pa0, pa1, pa2, pa3); pv_one<3>(o[3], vb, pa0, pa1, pa2, pa3);
}

struct Mask { int kind, nb, jlo, pq  , rk0, qr, qc  ; const LAS float* rpb; };
__device__ __forceinline__ void apply_mask(f32x16& p0, f32x16& p1, const Mask& M, int t, int hi) {
    if (t >= M.nb) return;
    const float NEG = -__builtin_inff();
#define CR(r) (((r) & 3) + 8 * ((r) >> 2))
    if (M.kind == 0) {
        const int jt = M.jlo + t;
        if (jt < 2) { const int lim = M.pq - 64 * jt - 4 * hi;
#pragma unroll
            for (int r = 0; r < 16; ++r) { p0[r] = (CR(r) >= lim) ? p0[r] : NEG; p1[r] = (CR(r) + 32 >= lim) ? p1[r] : NEG; }
        } else if (jt >= 4) { const int lim = M.pq - 64 * (jt - 4) - 4 * hi;
#pragma unroll
            for (int r = 0; r < 16; ++r) { p0[r] = (CR(r) <= lim) ? p0[r] : NEG; p1[r] = (CR(r) + 32 <= lim) ? p1[r] : NEG; }
        }
    } else if (M.kind == 1) {
        const int kr = M.rk0 + t; int r0q = M.qr - 4; r0q = r0q < 0 ? 0 : (r0q > 120 ? 120 : r0q);
        const bool rowok = (kr >= r0q) && (kr < r0q + 8);
        int dr = kr - M.qr + 7; dr = dr < 0 ? 0 : (dr > 14 ? 14 : dr);
        int c0 = M.qc - 8; c0 = c0 < 0 ? 0 : (c0 > 48 ? 48 : c0);
        const int c0h = rowok ? (c0 - 4 * hi) : 1000;
        const LAS float* tb = M.rpb + dr * 31 + (15 - M.qc) + 4 * hi;
#pragma unroll
        for (int r = 0; r < 16; ++r) { const float b0 = tb[CR(r)]; p0[r] = ((unsigned)(CR(r) - c0h) < 16u) ? p0[r] + b0 : NEG; }
        SBAR();
#pragma unroll
        for (int r = 0; r < 16; ++r) { const float b1 = tb[CR(r) + 32]; p1[r] = ((unsigned)(CR(r) + 32 - c0h) < 16u) ? p1[r] + b1 : NEG; }
    }
#undef CR
}

__device__ __forceinline__ void attn_unit(const bf16_t* __restrict__ P, bf16_t* __restrict__ MIX, const float* __restrict__ sinkp, const float* __restrict__ rpbp,
                                          int kind, int b, int i1, int i2, LAS char* lds) {
    int tid = threadIdx.x; asm volatile("" : "+v"(tid));
    const int wid = __builtin_amdgcn_readfirstlane(tid >> 6), lane = tid & 63, r32 = lane & 31, hi = lane >> 5;
    LAS char* V_lds = lds + OFF_V; LAS char* K_lds = lds + OFF_K;
    LAS float* wsf = (LAS float*)(lds + OFF_WS) + wid * 64; LAS float* li_l = wsf; LAS float* al_l = wsf + 32;
    LAS float* rpb_l = (LAS float*)(lds + OFF_RPB);
    int qbase, qcol, ocol, nb, row0, kcol, vcol; float sink2 = -__builtin_inff();
    Mask MK; MK.kind = kind; MK.jlo = 0; MK.pq = 0; MK.rk0 = 0; MK.qr = 0; MK.qc = 0; MK.rpb = rpb_l;
    if (kind == 0) {
        const int n = i1, kvh = i2 >> 1, gp = i2 & 1, g = 2 * gp + (wid >> 2), qh = 4 * kvh + g, p0q = 32 * (wid & 3);
        qbase = b * SEQ + n * 128 + p0q; qcol = PC_WQ + qh * 128; ocol = 1024 + qh * 128;
        const int jlo = (n == 0) ? 2 : 0, jhi = (n == SEQ / 128 - 1) ? 4 : 6; nb = jhi - jlo; row0 = b * SEQ + (n - 1) * 128 + 64 * jlo;
        kcol = PC_WK + kvh * 128; vcol = PC_WV + kvh * 128; sink2 = sinkp[qh] * LOG2E;
        MK.jlo = jlo; MK.pq = p0q + r32;
    } else if (kind == 1) {
        const int r = 4 * i1, h = i2, qr = r + (wid >> 1), c32 = 32 * (wid & 1);
        qbase = b * SEQ + qr * 64 + c32; qcol = PC_NQ + h * 128; ocol = h * 128;
        int rk0 = r - 4; rk0 = rk0 < 0 ? 0 : (rk0 > 116 ? 116 : rk0); nb = 12; row0 = b * SEQ + rk0 * 64;
        kcol = PC_NK + h * 128; vcol = PC_NV + h * 128;
        MK.rk0 = rk0; MK.qr = qr; MK.qc = c32 + r32;
        if (tid < 15 * 31) rpb_l[tid] = rpbp[h * (15 * 31) + tid] * LOG2E;
    } else if (kind == 2) {
        const int h = i1; qbase = ML + b * NCTX + 32 * wid; qcol = PC_NQ + h * 128; ocol = h * 128; nb = 0; row0 = 0; kcol = PC_NK + h * 128; vcol = PC_NV + h * 128;
    } else {
        const int qh = i1, kvh = qh >> 2; qbase = ML + b * NCTX + 32 * wid; qcol = PC_WQ + qh * 128; ocol = 1024 + qh * 128; nb = 0; row0 = 0;
        kcol = PC_WK + kvh * 128; vcol = PC_WV + kvh * 128; sink2 = sinkp[qh] * LOG2E;
    }
    MK.nb = nb;
    const int crow0 = ML + b * NCTX, NT = nb + 4;
    float m_reg = -1e30f, l_reg = 0; f32x16 o[4] = {}; bf16x8 qr[8];
    { const bf16_t* Qw = P + (size_t)(qbase + r32) * INW + qcol + hi * 8;
#pragma unroll
      for (int d0 = 0; d0 < 8; ++d0) qr[d0] = *(const bf16x8*)(Qw + d0 * 16); }
    const int sr = tid >> 4, sc = (tid & 15) * 8, vst0 = v_st(sr, sc), vst1 = v_st(32 + sr, sc);
    const int vb0 = (int)(unsigned)(size_t)V_lds + v_rd_base(lane);
#define TROW(t) (((t) < nb) ? (row0 + 64 * (t)) : (crow0 + 64 * ((t) - nb)))
#define RESC(a) do { if (__any((a) < 1.f)) { if (hi == 0) al_l[r32] = (a); asm volatile("s_waitcnt lgkmcnt(0)" ::: "memory"); \
    _Pragma("unroll") for (int d = 0; d < 4; ++d) _Pragma("unroll") for (int r = 0; r < 16; ++r) o[d][r] *= al_l[crow(r, hi)]; } } while (0)
#if ATT_PIPE2
    struct { bf16x8 vs0, vs1, ks0, ks1; } sr_[2];
#define SLOAD(i, t) do { const bf16_t* _b = P + (size_t)(TROW(t) + sr) * INW + sc; \
    sr_[i].vs0 = *(const bf16x8*)(_b + vcol); sr_[i].vs1 = *(const bf16x8*)(_b + (size_t)32 * INW + vcol); \
    sr_[i].ks0 = *(const bf16x8*)(_b + kcol); sr_[i].ks1 = *(const bf16x8*)(_b + (size_t)32 * INW + kcol); } while (0)
#define SWRITE(bb, i) do { *(LAS bf16x8*)(V_lds + (bb) * SHM_V + vst0) = sr_[i].vs0; *(LAS bf16x8*)(V_lds + (bb) * SHM_V + vst1) = sr_[i].vs1; const int kc_ = sc * 2; \
    *(LAS bf16x8*)(K_lds + (bb) * SHM_K + KSWZ(sr, kc_)) = sr_[i].ks0; *(LAS bf16x8*)(K_lds + (bb) * SHM_K + KSWZ(32 + sr, kc_)) = sr_[i].ks1; } while (0)
#define SWAIT() asm volatile("s_waitcnt vmcnt(4)" ::: "memory")
    f32x16 pA0, pA1, pB0, pB1; float mnA, mnB, alA, alB; bf16x8 pa0, pa1, pa2, pa3;
    constexpr int SE = 0, SO = 1;
    SLOAD(SE, 0); asm volatile("s_waitcnt vmcnt(0)" ::: "memory"); SWRITE(0, SE); __syncthreads();
    qkt(pA0, pA1, K_lds, qr, r32, hi); apply_mask(pA0, pA1, MK, 0, hi); partialSM(pA0, pA1, m_reg, mnA, alA);
    SLOAD(SO, 1); if (2 < NT) SLOAD(SE, 2);
    SWAIT(); SWRITE(1, SO); __syncthreads();
    for (int j = 1; j + 1 < NT; j += 2) {
        SBAR(); qkt(pB0, pB1, K_lds + SHM_K, qr, r32, hi);
        finishSM(pA0, pA1, alA, l_reg, pa0, pa1, pa2, pa3); SBAR();
        SLOAD(SO, j + 2); SBAR();
        pv_d0(o, vb0, pa0, pa1, pa2, pa3); apply_mask(pB0, pB1, MK, j, hi); partialSM(pB0, pB1, m_reg, mnB, alB);
        __syncthreads(); SWAIT(); SWRITE(0, SE);
        RESC(alB); __syncthreads();
        SBAR(); qkt(pA0, pA1, K_lds, qr, r32, hi);
        finishSM(pB0, pB1, alB, l_reg, pa0, pa1, pa2, pa3); SBAR();
        if (j + 3 < NT) SLOAD(SE, j + 3); SBAR();
        pv_d0(o, vb0 + SHM_V, pa0, pa1, pa2, pa3); apply_mask(pA0, pA1, MK, j + 1, hi); partialSM(pA0, pA1, m_reg, mnA, alA);
        __syncthreads(); SWAIT(); SWRITE(1, SO);
        RESC(alA); __syncthreads();
    }
    SBAR(); qkt(pB0, pB1, K_lds + SHM_K, qr, r32, hi);
    finishSM(pA0, pA1, alA, l_reg, pa0, pa1, pa2, pa3); SBAR();
    pv_d0(o, vb0, pa0, pa1, pa2, pa3); apply_mask(pB0, pB1, MK, NT - 1, hi); partialSM(pB0, pB1, m_reg, mnB, alB);
    __syncthreads(); RESC(alB);
    finishSM(pB0, pB1, alB, l_reg, pa0, pa1, pa2, pa3); SBAR();
    pv_d0(o, vb0 + SHM_V, pa0, pa1, pa2, pa3);
#undef SWAIT
#else
    bf16x8 vs0, vs1, ks0, ks1;
#define SLOAD(t) do { const bf16_t* _b = P + (size_t)(TROW(t) + sr) * INW + sc; \
    vs0 = *(const bf16x8*)(_b + vcol); vs1 = *(const bf16x8*)(_b + (size_t)32 * INW + vcol); \
    ks0 = *(const bf16x8*)(_b + kcol); ks1 = *(const bf16x8*)(_b + (size_t)32 * INW + kcol); } while (0)
#define SWRITE(bb) do { *(LAS bf16x8*)(V_lds + (bb) * SHM_V + vst0) = vs0; *(LAS bf16x8*)(V_lds + (bb) * SHM_V + vst1) = vs1; const int kc_ = sc * 2; \
    *(LAS bf16x8*)(K_lds + (bb) * SHM_K + KSWZ(sr, kc_)) = ks0; *(LAS bf16x8*)(K_lds + (bb) * SHM_K + KSWZ(32 + sr, kc_)) = ks1; } while (0)
    SLOAD(0); asm volatile("s_waitcnt vmcnt(0)" ::: "memory"); SWRITE(0); SLOAD(1); __syncthreads();
    for (int j = 0; j < NT; ++j) {
        const int bsel = j & 1;
        f32x16 p0, p1; float mn, al; bf16x8 pa0, pa1, pa2, pa3;
        qkt(p0, p1, K_lds + bsel * SHM_K, qr, r32, hi);
        apply_mask(p0, p1, MK, j, hi);
        partialSM(p0, p1, m_reg, mn, al);
        RESC(al);
        finishSM(p0, p1, al, l_reg, pa0, pa1, pa2, pa3);
        pv_d0(o, vb0 + bsel * SHM_V, pa0, pa1, pa2, pa3);
        if (j + 1 < NT) { asm volatile("s_waitcnt vmcnt(0)" ::: "memory"); SWRITE(bsel ^ 1); if (j + 2 < NT) SLOAD(j + 2); }
        __syncthreads();
    }
#endif
    l_reg += __builtin_amdgcn_exp2f(sink2 - m_reg);
    if (hi == 0) li_l[r32] = l_reg; asm volatile("s_waitcnt lgkmcnt(0)" ::: "memory");
    LAS char* ost = lds + OFF_OST + wid * OST_WAVE;
#pragma unroll
    for (int r = 0; r < 16; ++r) { const int orow = crow(r, hi); const float rl = __builtin_amdgcn_rcpf(li_l[orow]);
#pragma unroll
        for (int d0 = 0; d0 < 4; ++d0) *(LAS unsigned short*)(ost + orow * 272 + (d0 * 32 + r32) * 2) = (unsigned short)f2bf(o[d0][r] * rl); }
    asm volatile("s_waitcnt lgkmcnt(0)" ::: "memory");
#pragma unroll
    for (int i = 0; i < 8; ++i) { const int id = i * 64 + lane, rr = id >> 4, c16 = id & 15;
        const u32x4 v = *(const LAS u32x4*)(ost + rr * 272 + c16 * 16);
        *(u32x4*)(MIX + (size_t)(qbase + rr) * DM + ocol + c16 * 8) = v; }
#undef TROW
#undef SLOAD
#undef SWRITE
#undef RESC
}
}

#define XB_TMO      128
#define XB_XCNT(j)  (256  + 64 * (j))
#define XB_XSUB(j)  (1280 + 64 * (j))
#define XB_XGEN(j)  (2304 + 64 * (j))
#define XB_TOP      3328
#define XB_TOPGEN   3392
#define XCD_BAR_WORDS 3456
#define XB_SPIN_CAP (1u << 18)
__device__ __forceinline__ unsigned xb_ld(unsigned* p)              { return __hip_atomic_load(p, __ATOMIC_RELAXED, __HIP_MEMORY_SCOPE_AGENT); }
__device__ __forceinline__ unsigned xb_add(unsigned* p, unsigned v) { return __hip_atomic_fetch_add(p, v, __ATOMIC_RELAXED, __HIP_MEMORY_SCOPE_AGENT); }
__device__ __forceinline__ unsigned xb_xcc_id() { return (unsigned)__builtin_amdgcn_s_getreg((3 << 11) | 20) & 0xFu; }
#define XB_SPIN(cond, bar) do { unsigned _sp = 0; while (cond) { __builtin_amdgcn_s_sleep(1); \
    if ((++_sp & 255u) == 0u) { if (xb_ld(&(bar)[XB_TMO])) break; if (_sp > XB_SPIN_CAP) { atomicAdd(&(bar)[XB_TMO], 1u); break; } } } } while (0)
struct XcdBarrier { unsigned* bar; unsigned x; volatile LAS unsigned* st; };
__device__ __forceinline__ XcdBarrier xcd_barrier_post(unsigned* bar, volatile LAS unsigned* st) {
    XcdBarrier b; b.bar = bar; b.x = xb_xcc_id(); b.st = st;
    if (threadIdx.x == 0) (void)xb_add(&bar[XB_XCNT(b.x)], 1u);
    return b;
}
__device__ __forceinline__ void xcd_barrier_complete(unsigned* bar, unsigned x, unsigned& nloc, unsigned& nx) {
    const unsigned G = gridDim.x * gridDim.y * gridDim.z;
    unsigned sum, cnt, mine, sp = 0u;
    for (;;) {
        sum = 0u; cnt = 0u; mine = 0u;
#pragma unroll
        for (unsigned j = 0; j < 16; ++j) { const unsigned c = xb_ld(&bar[XB_XCNT(j)]); sum += c; cnt += (c > 0u) ? 1u : 0u; mine = (j == x) ? c : mine; }
        if (sum == G) break;
        __builtin_amdgcn_s_sleep(1);
        if ((++sp & 255u) == 0u) { if (xb_ld(&bar[XB_TMO])) break; if (sp > XB_SPIN_CAP) { atomicAdd(&bar[XB_TMO], 1u); break; } }
    }
    nloc = mine > 0u ? mine : 1u; nx = cnt > 0u ? cnt : 1u;
}
__device__ __forceinline__ void xcd_barrier(const XcdBarrier& b) {
    asm volatile("s_waitcnt vmcnt(0)" ::: "memory");
    __syncthreads();
    if (threadIdx.x == 0) {
        unsigned* bar = b.bar;
        __builtin_amdgcn_s_waitcnt(0);
        unsigned nloc = b.st[0], nx = b.st[1];
        if (nloc == 0u) { xcd_barrier_complete(bar, b.x, nloc, nx); b.st[0] = nloc; b.st[1] = nx; }
        const unsigned old = xb_add(&bar[XB_XSUB(b.x)], 1u);
        const unsigned gen = old / nloc;
        if (old + 1u == (gen + 1u) * nloc) {
            __builtin_amdgcn_fence(__ATOMIC_RELEASE, "agent");
            asm volatile("s_waitcnt vmcnt(0)" ::: "memory");
            const unsigned og = xb_add(&bar[XB_TOP], 1u);
            const unsigned tg = og / nx;
            if (og + 1u == (tg + 1u) * nx) xb_add(&bar[XB_TOPGEN], 1u);
            else XB_SPIN(xb_ld(&bar[XB_TOPGEN]) == tg, bar);
            __builtin_amdgcn_fence(__ATOMIC_ACQUIRE, "agent");
            xb_add(&bar[XB_XGEN(b.x)], 1u);
            asm volatile("s_waitcnt vmcnt(0)" ::: "memory");
        } else {
            XB_SPIN(xb_ld(&bar[XB_XGEN(b.x)]) == gen, bar);
            __builtin_amdgcn_fence(__ATOMIC_ACQUIRE, "agent");
            asm volatile("s_waitcnt vmcnt(0)" ::: "memory");
        }
    }
    __syncthreads();
}

__device__ __forceinline__ int wt_dest_row(int n0, int N, bool swiglu) {
    if (!swiglu) return n0;
    const int half = N / 2; const int j = (n0 < half) ? n0 : n0 - half; return 256 * (j >> 7) + (j & 127) + ((n0 < half) ? 0 : 128);
}
__device__ __forceinline__ void transpose_item(const float* __restrict__ W, int K, int N, bf16_t* __restrict__ WT, bool swiglu, int item, int lane) {
    const int nblk = N / 64, kb = item / nblk, nbi = item - kb * nblk, k0 = 64 * kb, n0 = 64 * nbi;
    const int k8 = lane & 7, n4 = lane >> 3;
    const float* src = W + (size_t)(k0 + 8 * k8) * N + n0 + 4 * n4;
    f32x4 v[2][8];
#pragma unroll
    for (int h = 0; h < 2; ++h)
#pragma unroll
        for (int i = 0; i < 8; ++i) v[h][i] = __builtin_nontemporal_load((const f32x4*)(src + (size_t)i * N + 32 * h));
#pragma unroll
    for (int h = 0; h < 2; ++h) { const int d0 = wt_dest_row(n0 + 32 * h, N, swiglu);
        bf16_t* dst = WT + (size_t)(d0 + 4 * n4) * K + k0 + 8 * k8;
#pragma unroll
        for (int j = 0; j < 4; ++j) { u32x4 o; o.x = cvt_pk_bf16(v[h][0][j], v[h][1][j]); o.y = cvt_pk_bf16(v[h][2][j], v[h][3][j]); o.z = cvt_pk_bf16(v[h][4][j], v[h][5][j]); o.w = cvt_pk_bf16(v[h][6][j], v[h][7][j]);
            *(u32x4*)(dst + (size_t)j * K) = o; } }
}
__device__ __forceinline__ float silu_f(float x) { return x / (1.0f + __expf(-x)); }
__device__ __forceinline__ void sincos_small(float a, float& c, float& s) {
    const float n = rintf(a * 0.63661977236758134f);
    float r = fmaf(-n, 1.57079637050628662109375f, a); r = fmaf(n, 4.37113900018624283e-8f, r);
    const float z = r * r;
    const float sp = r + r * z * (-1.6666654611e-1f + z * (8.3321608736e-3f + z * (-1.9515295891e-4f)));
    const float cp = 1.0f - 0.5f * z + z * z * (4.166664568298827e-2f + z * (-1.388731625493765e-3f + z * 2.443315711809948e-5f));
    const int q = ((int)n) & 3;
    c = (q == 0) ? cp : (q == 1) ? -sp : (q == 2) ? -cp : sp;
    s = (q == 0) ? sp : (q == 1) ? cp : (q == 2) ? -sp : -cp;
}

__device__ __forceinline__ void norm_phase(const float* xl, const float* xc, const float* g, const float* modl, int shift_chunk, int scale_chunk, bf16_t* H, int nrows, int gw, int ngw, int lane) {
    for (int row = gw; row < nrows; row += ngw) {
        const float* xr = (row < ML) ? xl + (size_t)row * DM : xc + (size_t)(row - ML) * DM;
        const int s = (row < ML) ? (row >> 13) : 4;
        const f32x4* sh = (const f32x4*)(modl + (size_t)s * MODW + shift_chunk * DM); const f32x4* scp = (const f32x4*)(modl + (size_t)s * MODW + scale_chunk * DM);
        f32x4 v[8]; float ss = 0.f;
#pragma unroll
        for (int j = 0; j < 8; ++j) { v[j] = ((const f32x4*)xr)[lane + 64 * j]; ss += (v[j].x * v[j].x + v[j].y * v[j].y) + (v[j].z * v[j].z + v[j].w * v[j].w); }
        const float rstd = 1.0f / sqrtf(wave_sum(ss) * (1.0f / DM) + 1e-6f);
        u32x2* o8 = (u32x2*)(H + (size_t)row * DM) + lane;
#pragma unroll
        for (int j = 0; j < 8; ++j) { const f32x4 gj = ((const f32x4*)g)[lane + 64 * j], sj = scp[lane + 64 * j], hj = sh[lane + 64 * j];
            const f32x4 y = v[j] * rstd * gj * (sj + 1.0f) + hj;
            u32x2 w; w.x = cvt_pk_bf16(y.x, y.y); w.y = cvt_pk_bf16(y.z, y.w); o8[64 * j] = w; }
    }
}

__device__ __forceinline__ void prep_phase(bf16_t* P, const float* na_gain, const float* wa_gain, const float* rope, int gthread, int nthreads) {
    const int sub = gthread & 15;
    for (int item = gthread >> 4; item < MT * 18; item += (nthreads >> 4)) {
        const int row = item / 18, hx = item - row * 18;
        int col; bool isq, iswa;
        if (hx < 4) { col = PC_NQ + 128 * hx; isq = true; iswa = false; }
        else if (hx < 8) { col = PC_NK + 128 * (hx - 4); isq = false; iswa = false; }
        else if (hx < 16) { col = PC_WQ + 128 * (hx - 8); isq = true; iswa = true; }
        else { col = PC_WK + 128 * (hx - 16); isq = false; iswa = true; }
        bf16_t* p = P + (size_t)row * INW + col + 8 * sub;
        const u32x4 raw = *(const u32x4*)p;
        float v[8];
        v[0] = __builtin_bit_cast(float, raw.x << 16); v[1] = __builtin_bit_cast(float, raw.x & 0xffff0000u);
        v[2] = __builtin_bit_cast(float, raw.y << 16); v[3] = __builtin_bit_cast(float, raw.y & 0xffff0000u);
        v[4] = __builtin_bit_cast(float, raw.z << 16); v[5] = __builtin_bit_cast(float, raw.z & 0xffff0000u);
        v[6] = __builtin_bit_cast(float, raw.w << 16); v[7] = __builtin_bit_cast(float, raw.w & 0xffff0000u);
        float ss = 0.f;
#pragma unroll
        for (int j = 0; j < 8; ++j) ss += v[j] * v[j];
        ss += __shfl_xor(ss, 1); ss += __shfl_xor(ss, 2); ss += __shfl_xor(ss, 4); ss += __shfl_xor(ss, 8);
        const float rstd = 1.0f / sqrtf(ss * (1.0f / 128.0f) + 1e-6f);
        const float* gn = (iswa ? wa_gain : na_gain) + (isq ? 0 : 128) + 8 * sub;
        const f32x4 g0 = *(const f32x4*)gn, g1 = *(const f32x4*)(gn + 4);
        v[0] *= rstd * g0.x; v[1] *= rstd * g0.y; v[2] *= rstd * g0.z; v[3] *= rstd * g0.w; v[4] *= rstd * g1.x; v[5] *= rstd * g1.y; v[6] *= rstd * g1.z; v[7] *= rstd * g1.w;
        if (iswa) {
            float pv[8];
#pragma unroll
            for (int j = 0; j < 8; ++j) pv[j] = __shfl_xor(v[j], 4);
            if (row < ML) {
                const int t = row & (SEQ - 1), pos = (sub >= 8) ? (t & 63) : (t >> 6);
                const int i0 = (8 * sub) & 31; const bool first = ((8 * sub) & 63) < 32;
                const float* tp = rope + ((size_t)pos * 32 + i0) * 2;
#pragma unroll
                for (int j = 0; j < 8; ++j) { const float c = tp[2 * j], s = tp[2 * j + 1]; v[j] = first ? (v[j] * c - pv[j] * s) : (v[j] * c + pv[j] * s); }
            }
        }
        if (isq) {
#pragma unroll
            for (int j = 0; j < 8; ++j) v[j] *= QSCALE;
        }
        u32x4 o; o.x = cvt_pk_bf16(v[0], v[1]); o.y = cvt_pk_bf16(v[2], v[3]); o.z = cvt_pk_bf16(v[4], v[5]); o.w = cvt_pk_bf16(v[6], v[7]);
        *(u32x4*)p = o;
    }
}

constexpr int POOL_A_OFF = 0, POOL_AS = 272, POOL_B_OFF = 256 * POOL_AS, POOL_LDS_END = POOL_B_OFF + 128 * POOL_AS;
static_assert(POOL_LDS_END <= LDSCTL_OFF, "pool LDS map");
template <int WIN> __device__ __forceinline__ void pool_a_tile(const bf16_t* __restrict__ up  , int t0, int L, int tid, LAS char* lds) {
#pragma unroll 2
    for (int it = 0; it < 8; ++it) { const int item = it * 512 + tid, row = item >> 4, cg = item & 15, t = t0 + row;
        float s[8], ctr[8];
#pragma unroll
        for (int j = 0; j < 8; ++j) s[j] = 0.f;
#pragma unroll
        for (int w = 0; w < WIN; ++w) { const int tt = t - WIN / 2 + w; const bool ok = (tt >= 0) && (tt < L); const int tc = tt < 0 ? 0 : (tt > L - 1 ? L - 1 : tt);
            const u32x4 raw = *(const u32x4*)(up + (size_t)tc * INW + 8 * cg); const float m = ok ? 1.f : 0.f;
            float f[8]; f[0] = __builtin_bit_cast(float, raw.x << 16); f[1] = __builtin_bit_cast(float, raw.x & 0xffff0000u); f[2] = __builtin_bit_cast(float, raw.y << 16); f[3] = __builtin_bit_cast(float, raw.y & 0xffff0000u);
            f[4] = __builtin_bit_cast(float, raw.z << 16); f[5] = __builtin_bit_cast(float, raw.z & 0xffff0000u); f[6] = __builtin_bit_cast(float, raw.w << 16); f[7] = __builtin_bit_cast(float, raw.w & 0xffff0000u);
#pragma unroll
            for (int j = 0; j < 8; ++j) { s[j] = fmaf(f[j], m, s[j]); if (w == WIN / 2) ctr[j] = f[j]; } }
        int lo = t - WIN / 2; lo = lo < 0 ? 0 : lo; int hi_ = t + WIN / 2 - 1; hi_ = hi_ > L - 1 ? L - 1 : hi_;
        const float inv = 1.0f / (float)(hi_ - lo + 1);
        u32x4 o; o.x = cvt_pk_bf16(s[0] * inv - ctr[0], s[1] * inv - ctr[1]); o.y = cvt_pk_bf16(s[2] * inv - ctr[2], s[3] * inv - ctr[3]);
        o.z = cvt_pk_bf16(s[4] * inv - ctr[4], s[5] * inv - ctr[5]); o.w = cvt_pk_bf16(s[6] * inv - ctr[6], s[7] * inv - ctr[7]);
        *(LAS u32x4*)(lds + POOL_A_OFF + row * POOL_AS + cg * 16) = o; }
}
__device__ __forceinline__ void pool_unit(const bf16_t* __restrict__ P, bf16_t* __restrict__ MIX, const float* __restrict__ pw, const float* __restrict__ pscale, int pm, int g, LAS char* lds) {
    int tid = threadIdx.x; asm volatile("" : "+v"(tid));
    const int wid = tid >> 6, lane = tid & 63, r32 = lane & 31, hi = lane >> 5;
    const int rowbase = pm * 256;
    int seq0, L; if (pm < ML / 256) { seq0 = (pm >> 5) * SEQ; L = SEQ; } else { seq0 = ML + (pm - ML / 256) * NCTX; L = NCTX; }
    __syncthreads();
    { const bf16_t* up = P + (size_t)seq0 * INW + PC_U + g * 128; const int t0 = rowbase - seq0;
      if (g == 0) pool_a_tile<2>(up, t0, L, tid, lds); else if (g == 1) pool_a_tile<4>(up, t0, L, tid, lds); else if (g == 2) pool_a_tile<8>(up, t0, L, tid, lds); else pool_a_tile<16>(up, t0, L, tid, lds);
      for (int idx = tid; idx < 128 * 128; idx += 512) { const int cc = idx >> 7, e = idx & 127;
          *(LAS unsigned short*)(lds + POOL_B_OFF + e * POOL_AS + cc * 2) = (unsigned short)f2bf(pw[(size_t)g * 16384 + idx]); } }
    __syncthreads();
    f32x16 acc[4] = {};
#pragma unroll
    for (int ks = 0; ks < 8; ++ks) { const bf16x8 a = *(const LAS bf16x8*)(lds + POOL_A_OFF + (32 * wid + r32) * POOL_AS + (16 * ks + 8 * hi) * 2);
#pragma unroll
        for (int nbk = 0; nbk < 4; ++nbk) { const bf16x8 bb = *(const LAS bf16x8*)(lds + POOL_B_OFF + (32 * nbk + r32) * POOL_AS + (16 * ks + 8 * hi) * 2);
            acc[nbk] = __builtin_amdgcn_mfma_f32_32x32x16_bf16(a, bb, acc[nbk], 0, 0, 0); } }
#pragma unroll
    for (int nbk = 0; nbk < 4; ++nbk) { const int e = 32 * nbk + r32; const float sc = pscale[g * 128 + e];
#pragma unroll
        for (int r = 0; r < 16; ++r) { const int row = rowbase + 32 * wid + att::crow(r, hi);
            MIX[(size_t)row * DM + 512 + g * 128 + e] = (bf16_t)f2bf(acc[nbk][r] * sc); } }
}

constexpr int NPH = 1 + 11 * DEPTH;
struct Args { const float* in[19]; float* out; unsigned char* ws; int ph_lo, ph_hi; };

template <int PHMASK> __global__ void __launch_bounds__(512, 2) fwd_kernel(Args args) {
    extern __shared__ __attribute__((aligned(16))) unsigned char lds_raw[];
    LAS unsigned char* lds = (LAS unsigned char*)lds_raw;
    const int G = gridDim.x, ngw = G * 8;
#define PHASE_IDS() int tid = threadIdx.x; asm volatile("" : "+v"(tid)); const int lane = tid & 63, wave = __builtin_amdgcn_readfirstlane(tid >> 6); \
    int bx = blockIdx.x; asm volatile("" : "+s"(bx)); const int vcu = (G % 8 == 0) ? (bx % 8) * (G / 8) + bx / 8 : bx; const int gw = vcu * 8 + wave; (void)lane; (void)gw; (void)vcu
    unsigned char* ws = args.ws;
    unsigned* ctl = (unsigned*)(ws + WS_CTL);
    float* MOD = (float*)(ws + WS_MOD);
    float* ROPE = (float*)(ws + WS_ROPE);
    float* XC = (float*)(ws + WS_XC);
    float* DUML = (float*)(ws + WS_END); float* DUMC = (float*)(ws + WS_END + 256 * MiB);
    bf16_t* H = (bf16_t*)(ws + WS_H); bf16_t* HID = (bf16_t*)(ws + WS_HID); bf16_t* P = (bf16_t*)(ws + WS_P); bf16_t* MIX = (bf16_t*)(ws + WS_MIX);
    const float* x_in = args.in[0]; const float* c_in = args.in[1]; const float* ctx_in = args.in[2]; const float* cctx_in = args.in[3];
    const float* w_mod = args.in[4]; const float* b_mod = args.in[5]; const float* norm_w = args.in[6];
    const float* na_gain = args.in[13]; const float* na_rpb = args.in[14]; const float* pool_w = args.in[15]; const float* pool_scale = args.in[16];
    const float* wa_gain = args.in[17]; const float* wa_sink = args.in[18];
    float* xout = args.out;

    { const int t0 = threadIdx.x; if (t0 < 128) ((LAS unsigned*)(lds + LDSCTL_OFF))[t0] = 0u; }
    __syncthreads();
    const int lo = args.ph_lo, hi = args.ph_hi;
#if MK_SINGLE
    XcdBarrier bar = xcd_barrier_post(ctl + CW_BAR, (volatile LAS unsigned*)(lds + LDSCTL_OFF + 32));
#define GRID_BAR() xcd_barrier(bar)
#else
#define GRID_BAR() do { } while (0)
#endif
#define IN(k) (lo <= (k) && (k) < hi)
#define PHON(k) ((PHMASK >> (k)) & 1)
#define DUPREP(k) _Pragma("unroll") for (int rep = 0; rep <= ((DUPMASK >> (k)) & 1); ++rep)
#define ISDUMMY(k) (rep < ((DUPMASK >> (k)) & 1))
#define SEAM(k) do { if (IN((k) + 1)) GRID_BAR(); } while (0)

    if (PHON(0) && IN(0)) {
        PHASE_IDS();
        LAS float* scr = (LAS float*)(lds + wave * 16384);
        constexpr int I_WI = (DM / 64) * (2 * DFF / 64), I_WO = (DFF / 64) * (DM / 64), I_IN = (DM / 64) * (INW / 64), I_OUT = (DM / 64) * (DM / 64);
        constexpr int I_LAYER = 2 * I_WI + 2 * I_WO + I_IN + I_OUT;
        DUPREP(0)
        for (int it = gw; it < DEPTH * I_LAYER; it += ngw) {
            const int l = it / I_LAYER; int r = it - l * I_LAYER;
            unsigned char* wl = ws + WS_W + (size_t)l * W_LAYER;
            if (r < I_WI) { transpose_item(args.in[7] + (size_t)l * DM * 2 * DFF, DM, 2 * DFF, (bf16_t*)(wl + W_WI1), true, r, lane); continue; } r -= I_WI;
            if (r < I_WI) { transpose_item(args.in[9] + (size_t)l * DM * 2 * DFF, DM, 2 * DFF, (bf16_t*)(wl + W_WI2), true, r, lane); continue; } r -= I_WI;
            if (r < I_WO) { transpose_item(args.in[8] + (size_t)l * DFF * DM, DFF, DM, (bf16_t*)(wl + W_WO1), false, r, lane); continue; } r -= I_WO;
            if (r < I_WO) { transpose_item(args.in[10] + (size_t)l * DFF * DM, DFF, DM, (bf16_t*)(wl + W_WO2), false, r, lane); continue; } r -= I_WO;
            if (r < I_IN) { transpose_item(args.in[11] + (size_t)l * DM * INW, DM, INW, (bf16_t*)(wl + W_WIN), false, r, lane); continue; } r -= I_IN;
            transpose_item(args.in[12] + (size_t)l * DM * DM, DM, DM, (bf16_t*)(wl + W_WOUT), false, r, lane);
        }
        for (int it = gw; it < DEPTH * 72 * 16; it += ngw) {
            const int l = it / (72 * 16), r = it - l * (72 * 16), cc = r >> 4, ks = r & 15;
            LAS float* sv = scr;
            for (int i = lane; i < 5 * 128; i += 64) { const int s = i >> 7, k = ks * 128 + (i & 127); sv[i] = silu_f(s < 4 ? c_in[s * DM + k] : cctx_in[k]); }
            LDS_WAIT(); asm volatile("" ::: "memory");
            const float* wp = w_mod + ((size_t)l * DM + ks * 128) * MODW + cc * 256 + 4 * lane;
            f32x4 a0 = {0, 0, 0, 0}, a1 = a0, a2 = a0, a3 = a0, a4 = a0;
#pragma unroll 8
            for (int k = 0; k < 128; ++k) { const f32x4 w = *(const f32x4*)(wp + (size_t)k * MODW);
                a0 += w * sv[k]; a1 += w * sv[128 + k]; a2 += w * sv[256 + k]; a3 += w * sv[384 + k]; a4 += w * sv[512 + k]; }
            if (ks == 0) { const f32x4 bb = *(const f32x4*)(b_mod + (size_t)l * MODW + cc * 256 + 4 * lane); a0 += bb; a1 += bb; a2 += bb; a3 += bb; a4 += bb; }
            float* mo = MOD + (size_t)l * 5 * MODW + cc * 256 + 4 * lane;
#pragma unroll
            for (int j = 0; j < 4; ++j) { unsafeAtomicAdd(mo + j, a0[j]); unsafeAtomicAdd(mo + MODW + j, a1[j]); unsafeAtomicAdd(mo + 2 * MODW + j, a2[j]); unsafeAtomicAdd(mo + 3 * MODW + j, a3[j]); unsafeAtomicAdd(mo + 4 * MODW + j, a4[j]); }
            LDS_WAIT(); asm volatile("" ::: "memory");
        }
        { const int gt = gw * 64 + lane; if (gt < 128 * 32) { const int pos = gt >> 5, i = gt & 31; const float f = exp2f(-(float)i * 0.4152410118609203f); float c, s; sincos_small((float)pos * f, c, s); ROPE[2 * gt] = c; ROPE[2 * gt + 1] = s; } }
        SEAM(0);
    }

#pragma unroll LAYER_UNROLL
    for (int l = 0; l < DEPTH; ++l) {
        const int pb = 1 + 11 * l;
        unsigned char* wl = ws + WS_W + (size_t)l * W_LAYER;
        const float* modl = MOD + (size_t)l * 5 * MODW;
        const float* nw = norm_w + (size_t)l * 3 * DM;
        const float* xl_cur = (l == 0) ? x_in : xout;
        const float* xc_cur = (l == 0) ? ctx_in : XC;
        const bool lastl = (l == DEPTH - 1); const int MPOST = lastl ? ML : MT;

        if (PHON(1) && IN(pb + 0)) { DUPREP(1) { PHASE_IDS(); norm_phase(xl_cur, xc_cur, nw, modl, 0, 1, H, MT, gw, ngw, lane); } SEAM(pb + 0); }
        if (PHON(2) && IN(pb + 1)) {
            DUPREP(2) {
            PHASE_IDS();
            pg8::Gemm g{H, (const bf16_t*)(wl + W_WI1), MT, 2 * DFF, DM}; pg8::StaticOrder S; S.init(MT, 2 * DFF, G, bx);
            pg8::EpiSwiglu E{HID};
            pg8::gemm_phase<pg8::EpiSwiglu, pg8::StaticOrder, true, true>(lds, g, S, E);
            }
            SEAM(pb + 1);
        }
        if (PHON(3) && IN(pb + 2)) {
            DUPREP(3) {
            PHASE_IDS();
            pg8::Gemm g{HID, (const bf16_t*)(wl + W_WO1), MT, DM, DFF}; pg8::StaticOrder S; S.init(MT, DM, G, bx);
            pg8::EpiResid E{xl_cur, xc_cur, ISDUMMY(3) ? DUML : xout, ISDUMMY(3) ? DUMC : XC, modl + 2 * DM, 0.5f};
            pg8::gemm_phase<pg8::EpiResid, pg8::StaticOrder, true, true>(lds, g, S, E);
            }
            SEAM(pb + 2);
        }
        if (PHON(4) && IN(pb + 3)) { DUPREP(4) { PHASE_IDS(); norm_phase(xout, XC, nw + DM, modl, 3, 4, H, MT, gw, ngw, lane); } SEAM(pb + 3); }
        if (PHON(5) && IN(pb + 4)) {
            DUPREP(5) {
            PHASE_IDS();
            pg8::Gemm g{H, (const bf16_t*)(wl + W_WIN), MT, INW, DM}; pg8::StaticOrder S; S.init(MT, INW, G, bx);
            pg8::EpiBf16 E{P, INW};
            pg8::gemm_phase<pg8::EpiBf16, pg8::StaticOrder, true, true>(lds, g, S, E);
            }
            SEAM(pb + 4);
        }
        if (PHON(6) && IN(pb + 5)) { PHASE_IDS(); prep_phase(P, na_gain + (size_t)l * 256, wa_gain + (size_t)l * 256, ROPE, gw * 64 + lane, ngw * 64); SEAM(pb + 5); }
        if (PHON(7) && IN(pb + 6)) {
            DUPREP(7) {
            PHASE_IDS();
            const float* sinkp = wa_sink + l * 8; const float* rpbp = na_rpb + (size_t)l * 4 * 15 * 31;
            constexpr int U_WA = 1024, U_NA = 512;
            const int U_CN = lastl ? 0 : 16, U_CW = lastl ? 0 : 32, U_ATT = U_WA + U_NA + U_CN + U_CW, U_POOL = (MPOST / 256) * 4;
            for (int idx = vcu; idx < U_ATT + U_POOL; idx += G) {
                if (idx < U_WA) { att::attn_unit(P, MIX, sinkp, rpbp, 0, idx >> 8, (idx >> 2) & 63, idx & 3, (LAS char*)lds); }
                else if (idx < U_WA + U_NA) { const int r = idx - U_WA; att::attn_unit(P, MIX, sinkp, rpbp, 1, r >> 7, (r >> 2) & 31, r & 3, (LAS char*)lds); }
                else if (idx < U_WA + U_NA + U_CN) { const int r = idx - U_WA - U_NA; att::attn_unit(P, MIX, sinkp, rpbp, 2, r >> 2, r & 3, 0, (LAS char*)lds); }
                else if (idx < U_ATT) { const int r = idx - U_WA - U_NA - U_CN; att::attn_unit(P, MIX, sinkp, rpbp, 3, r >> 3, r & 7, 0, (LAS char*)lds); }
                else { const int r = idx - U_ATT; __syncthreads(); pool_unit(P, MIX, pool_w + (size_t)l * 4 * 16384, pool_scale + (size_t)l * 512, r >> 2, r & 3, (LAS char*)lds); }
            }
            }
            SEAM(pb + 6);
        }
        if (PHON(8) && IN(pb + 7)) {
            DUPREP(8) {
            PHASE_IDS();
            pg8::Gemm g{MIX, (const bf16_t*)(wl + W_WOUT), MPOST, DM, DM}; pg8::StaticOrder S; S.init(MPOST, DM, G, bx);
            pg8::EpiResid E{xout, XC, ISDUMMY(8) ? DUML : xout, ISDUMMY(8) ? DUMC : XC, modl + 5 * DM, 1.0f};
            pg8::gemm_phase<pg8::EpiResid, pg8::StaticOrder, true, true>(lds, g, S, E);
            }
            SEAM(pb + 7);
        }
        if (PHON(9) && IN(pb + 8)) { DUPREP(9) { PHASE_IDS(); norm_phase(xout, XC, nw + 2 * DM, modl, 6, 7, H, MPOST, gw, ngw, lane); } SEAM(pb + 8); }
        if (PHON(10) && IN(pb + 9)) {
            DUPREP(10) {
            PHASE_IDS();
            pg8::Gemm g{H, (const bf16_t*)(wl + W_WI2), MPOST, 2 * DFF, DM}; pg8::StaticOrder S; S.init(MPOST, 2 * DFF, G, bx);
            pg8::EpiSwiglu E{HID};
            pg8::gemm_phase<pg8::EpiSwiglu, pg8::StaticOrder, true, true>(lds, g, S, E);
            }
            SEAM(pb + 9);
        }
        if (PHON(11) && IN(pb + 10)) {
            DUPREP(11) {
            PHASE_IDS();
            pg8::Gemm g{HID, (const bf16_t*)(wl + W_WO2), MPOST, DM, DFF}; pg8::StaticOrder S; S.init(MPOST, DM, G, bx);
            pg8::EpiResid E{xout, XC, ISDUMMY(11) ? DUML : xout, ISDUMMY(11) ? DUMC : XC, modl + 8 * DM, 0.5f};
            pg8::gemm_phase<pg8::EpiResid, pg8::StaticOrder, true, true>(lds, g, S, E);
            }
            if (l + 1 < DEPTH) SEAM(pb + 10);
        }
    }
#undef IN
#undef SEAM
#undef GRID_BAR
}

template <int PHMASK> static bool prep_kernel(int& per_cu) {
    if (hipFuncSetAttribute((const void*)fwd_kernel<PHMASK>, hipFuncAttributeMaxDynamicSharedMemorySize, LDS_BYTES) != hipSuccess) { fprintf(stderr, "kernel_launch: hipFuncSetAttribute failed (mask %x)\n", PHMASK); return false; }
    if (hipOccupancyMaxActiveBlocksPerMultiprocessor(&per_cu, (const void*)fwd_kernel<PHMASK>, 512, LDS_BYTES) != hipSuccess || per_cu < 1) fprintf(stderr, "kernel_launch: occupancy query reports %d (mask %x)\n", per_cu, PHMASK);
    (void)hipGetLastError();
    return true;
}
template <int PHMASK> static void launch_k(int grid, const Args& a, hipStream_t stream) { hipLaunchKernelGGL(fwd_kernel<PHMASK>, dim3(grid), dim3(512), LDS_BYTES, stream, a); }
extern "C" void kernel_launch(void* const* d_in, const int* in_sizes, int n_in, void* d_out, int out_size, void* d_ws, size_t ws_size, hipStream_t stream) {
    static int grid = 0;
    if (grid == 0) {
        if (n_in != 19 || in_sizes[0] != ML * DM || out_size != ML * DM || ws_size < WS_END + (DUPMASK ? 264 * MiB : 0)) {
            fprintf(stderr, "kernel_launch: shape mismatch: n_in %d in0 %d out %d ws %zu (need %zu)\n", n_in, n_in > 0 ? in_sizes[0] : -1, out_size, ws_size, (size_t)WS_END); grid = -1; return; }
        int dev = 0, cus = 0, per_cu = 0; bool ok = true;
        if (hipGetDevice(&dev) != hipSuccess || hipDeviceGetAttribute(&cus, hipDeviceAttributeMultiprocessorCount, dev) != hipSuccess) { grid = -1; return; }
#if MK_SINGLE
        ok = prep_kernel<0xFFF>(per_cu);
#else
        ok = prep_kernel<1>(per_cu) && prep_kernel<2>(per_cu) && prep_kernel<4>(per_cu) && prep_kernel<8>(per_cu) && prep_kernel<16>(per_cu) && prep_kernel<32>(per_cu) && prep_kernel<64>(per_cu)
          && prep_kernel<128>(per_cu) && prep_kernel<256>(per_cu) && prep_kernel<512>(per_cu) && prep_kernel<1024>(per_cu) && prep_kernel<2048>(per_cu);
#endif
        if (!ok) { grid = -1; return; }
        grid = cus;
    }
    if (grid < 0) return;
    if (hipMemsetAsync((char*)d_ws + WS_CTL, 0, CTL_ZERO_BYTES, stream) != hipSuccess) { fprintf(stderr, "kernel_launch: memset failed\n"); return; }
    Args a{};
    for (int i = 0; i < 19; ++i) a.in[i] = (const float*)d_in[i];
    a.out = (float*)d_out; a.ws = (unsigned char*)d_ws;
#if MK_SINGLE
    a.ph_lo = 0; a.ph_hi = NPH;
    launch_k<0xFFF>(grid, a, stream);
#else
    for (int ph = 0; ph < NPH; ++ph) { a.ph_lo = ph; a.ph_hi = ph + 1;
        const int bit = (ph == 0) ? 0 : 1 + (ph - 1) % 11;
        switch (bit) { case 0: launch_k<1>(grid, a, stream); break; case 1: launch_k<2>(grid, a, stream); break; case 2: launch_k<4>(grid, a, stream); break; case 3: launch_k<8>(grid, a, stream); break;
            case 4: launch_k<16>(grid, a, stream); break; case 5: launch_k<32>(grid, a, stream); break; case 6: launch_k<64>(grid, a, stream); break; case 7: launch_k<128>(grid, a, stream); break;
            case 8: launch_k<256>(grid, a, stream); break; case 9: launch_k<512>(grid, a, stream); break; case 10: launch_k<1024>(grid, a, stream); break; default: launch_k<2048>(grid, a, stream); break; } }
#endif
    const hipError_t le = hipPeekAtLastError();
    if (le != hipSuccess) fprintf(stderr, "kernel_launch: launch failed: %s\n", hipGetErrorName(le));
}
```

```cpp
#include <hip/hip_runtime.h>
#include <cstdio>
#include <cstdint>

#ifndef DBG_MASK
#define DBG_MASK 0xFFF
#endif
#ifndef DUPMASK
#define DUPMASK 0
#endif
#ifndef ATT_PIPE2
#define ATT_PIPE2 1
#endif
#ifndef LAYER_UNROLL
#define LAYER_UNROLL 2
#endif
#ifndef MK_SINGLE
#define MK_SINGLE 1
#endif

#define GAS __attribute__((address_space(1)))
#define LAS __attribute__((address_space(3)))
typedef unsigned short bf16_t;
typedef short bf16x8 __attribute__((ext_vector_type(8)));
typedef short s16x4 __attribute__((ext_vector_type(4)));
typedef float f32x4 __attribute__((ext_vector_type(4)));
typedef float f32x16 __attribute__((ext_vector_type(16)));
typedef unsigned u32x4 __attribute__((ext_vector_type(4)));
typedef unsigned u32x2 __attribute__((ext_vector_type(2)));

constexpr int DM = 2048, NBATCH = 4, SEQ = 8192, NCTX = 256, DFF = 5632, INW = 3584, DEPTH = 2, MODW = 9 * DM;
constexpr int ML = NBATCH * SEQ, MC = NBATCH * NCTX, MT = ML + MC;
constexpr float LOG2E = 1.4426950408889634f;
constexpr float QSCALE = 0.088388347648318440f * LOG2E;
constexpr int PC_NQ = 0, PC_NK = 512, PC_NV = 1024, PC_U = 1536, PC_WQ = 2048, PC_WK = 3072, PC_WV = 3328;

constexpr size_t MiB = 1u << 20;
constexpr size_t WS_CTL = 0, CTL_ZERO_BYTES = 1 * MiB;
constexpr size_t WS_MOD = 256 * 1024;
constexpr size_t WS_ROPE = 1 * MiB;
constexpr size_t WS_W = 2 * MiB;
constexpr size_t W_WI1 = 0, W_WO1 = 44 * MiB, W_WIN = 66 * MiB, W_WOUT = 80 * MiB, W_WI2 = 88 * MiB, W_WO2 = 132 * MiB, W_LAYER = 154 * MiB;
constexpr size_t WS_XC = WS_W + 2 * W_LAYER;
constexpr size_t WS_H = WS_XC + 8 * MiB;
constexpr size_t WS_HID = WS_H + 132 * MiB;
constexpr size_t WS_P = WS_HID;
constexpr size_t WS_MIX = WS_HID + 231 * MiB;
constexpr size_t WS_END = WS_HID + 363 * MiB;
static_assert((size_t)MT * DFF * 2 == 363 * MiB && (size_t)MT * INW * 2 == 231 * MiB && (size_t)MT * DM * 2 == 132 * MiB, "ws map");
static_assert(WS_MOD + (size_t)DEPTH * 5 * MODW * 4 <= CTL_ZERO_BYTES, "MOD inside the zeroed region");
constexpr int CW_BAR = 4096;

constexpr int LDS_BYTES = 147456;
constexpr int LDSCTL_OFF = LDS_BYTES - 512;

__device__ __forceinline__ unsigned f2bf(float f) { unsigned u = __builtin_bit_cast(unsigned, f); return (u + 0x7fffu + ((u >> 16) & 1u)) >> 16; }
__device__ __forceinline__ unsigned cvt_pk_bf16(float lo, float hi) { unsigned r; asm volatile("v_cvt_pk_bf16_f32 %0, %1, %2" : "=v"(r) : "v"(lo), "v"(hi)); return r; }
__device__ __forceinline__ float bf2f(unsigned short b) { return __builtin_bit_cast(float, (unsigned)b << 16); }
__device__ __forceinline__ float wave_sum(float v) {
#pragma unroll
    for (int o = 1; o < 64; o <<= 1) v += __shfl_xor(v, o);
    return v;
}
#define LDS_WAIT() asm volatile("s_waitcnt lgkmcnt(0)" ::: "memory")
#define VM_WAIT() asm volatile("s_waitcnt vmcnt(0)" ::: "memory")

namespace pg8 {
constexpr int BM = 256, BK = 64, HALF = 128, HTB = HALF * BK * 2, STAGE_BYTES = 8 * HTB, NXCD = 8, WGM = 8;
__host__ __device__ __forceinline__ int lds_byte(int r, int c) { const int st = (r >> 4) * 2 + (c >> 5), rr = r & 15, cc = c & 31, ob = rr * 64 + cc * 2; return st * 1024 + (ob ^ (((ob >> 9) & 1) << 5)); }
__host__ __device__ __forceinline__ void stage_rc(int b, int& R, int& C) { const int st = b / 1024, sb = b % 1024, swz = sb ^ (((sb >> 9) & 1) << 5); R = (st >> 1) * 16 + swz / 64; C = (st & 1) * 32 + (swz % 64) / 2; }
__host__ __device__ __forceinline__ int perm32(int rho) { const int n = rho >> 4, i = rho & 15; return 8 * (i >> 2) + 4 * n + (i & 3); }
struct Unit { int pm, pn; unsigned koff; };
struct Gemm { const bf16_t* A; const bf16_t* Bt; int M, N, K, ld; };
struct StaticOrder {
    int nM, nN, nwg, G, c;
    __host__ __device__ void init(int M, int N, int G_, int c_) { nM = M / BM; nN = N / BM; nwg = nM * nN; G = G_; c = c_; }
    __host__ __device__ bool next(int i, Unit& u) const {
        const long L = (long)i * G + c; if (L >= nwg) return false;
        int wgid = (int)L; { const int q = nwg / NXCD, r = nwg % NXCD, xcd = wgid % NXCD, off = wgid / NXCD; wgid = (xcd < r ? xcd * (q + 1) : r * (q + 1) + (xcd - r) * q) + off; }
        const int nig = WGM * nN, gid = wgid / nig, fm = gid * WGM, gsz = (nM - fm) < WGM ? (nM - fm) : WGM;
        u.pm = fm + ((wgid % nig) % gsz); u.pn = (wgid % nig) / gsz; u.koff = 0u; return true;
    }
    __device__ __forceinline__ void a_ready(const Unit&) const {}
    __device__ __forceinline__ void done(const Unit&) const {}
};

struct EpiBf16 {
    static constexpr bool PERM = true, AFTER_DRAIN = false;
    bf16_t* O; int ldc;
    __device__ __forceinline__ void operator()(const f32x4 (&acc)[2][2][4][2], const Unit& u, int wr, int wc, int fr, int fq) const {
        const int row0 = u.pm * BM + wr * 64 + fr, col0 = u.pn * BM + wc * 32 + 8 * fq;
#pragma unroll
        for (int ai = 0; ai < 2; ++ai)
#pragma unroll
            for (int m = 0; m < 4; ++m) { bf16_t* rowp = O + (size_t)(row0 + ai * HALF + m * 16) * ldc + col0;
#pragma unroll
                for (int bj = 0; bj < 2; ++bj) { const f32x4 v0 = acc[ai][bj][m][0], v1 = acc[ai][bj][m][1];
                    u32x4 w; w.x = cvt_pk_bf16(v0[0], v0[1]); w.y = cvt_pk_bf16(v0[2], v0[3]); w.z = cvt_pk_bf16(v1[0], v1[1]); w.w = cvt_pk_bf16(v1[2], v1[3]);
                    *(u32x4*)(rowp + bj * HALF) = w; } }
    }
};
__device__ __forceinline__ float silu_mul(float a, float b) { return a * b * __builtin_amdgcn_rcpf(1.0f + __builtin_amdgcn_exp2f(-a * LOG2E)); }
struct EpiSwiglu {
    static constexpr bool PERM = true, AFTER_DRAIN = false;
    bf16_t* O;
    __device__ __forceinline__ void operator()(const f32x4 (&acc)[2][2][4][2], const Unit& u, int wr, int wc, int fr, int fq) const {
        const int row0 = u.pm * BM + wr * 64 + fr, col0 = u.pn * HALF + wc * 32 + 8 * fq;
#pragma unroll
        for (int ai = 0; ai < 2; ++ai)
#pragma unroll
            for (int m = 0; m < 4; ++m) { bf16_t* rowp = O + (size_t)(row0 + ai * HALF + m * 16) * DFF + col0;
                const f32x4 a0 = acc[ai][0][m][0], a1 = acc[ai][0][m][1], b0 = acc[ai][1][m][0], b1 = acc[ai][1][m][1];
                u32x4 w; w.x = cvt_pk_bf16(silu_mul(a0[0], b0[0]), silu_mul(a0[1], b0[1])); w.y = cvt_pk_bf16(silu_mul(a0[2], b0[2]), silu_mul(a0[3], b0[3]));
                w.z = cvt_pk_bf16(silu_mul(a1[0], b1[0]), silu_mul(a1[1], b1[1])); w.w = cvt_pk_bf16(silu_mul(a1[2], b1[2]), silu_mul(a1[3], b1[3]));
                *(u32x4*)rowp = w; }
    }
};
struct EpiResid {
    static constexpr bool PERM = false, AFTER_DRAIN = false;
    const float* xin_l; const float* xin_c; float* xout_l; float* xout_c; const float* gate; float gs;
    __device__ __forceinline__ void operator()(const f32x4 (&acc)[2][2][4][2], const Unit& u, int wr, int wc, int fr, int fq) const {
        const bool lat = u.pm < (ML / BM); const int s = lat ? (u.pm >> 5) : 4;
        const float* xi = lat ? xin_l + (size_t)u.pm * BM * DM : xin_c + (size_t)(u.pm - ML / BM) * BM * DM;
        float* xo = lat ? xout_l + (size_t)u.pm * BM * DM : xout_c + (size_t)(u.pm - ML / BM) * BM * DM;
        const int r0 = wr * 64 + fr, col0 = u.pn * BM + wc * 32 + 4 * fq;
        const float* gp = gate + (size_t)s * MODW + col0;
#pragma unroll
        for (int bj = 0; bj < 2; ++bj)
#pragma unroll
            for (int n = 0; n < 2; ++n) { const f32x4 gv = *(const f32x4*)(gp + bj * HALF + n * 16) * gs;
#pragma unroll
                for (int ai = 0; ai < 2; ++ai)
#pragma unroll
                    for (int m = 0; m < 4; ++m) { const size_t off = (size_t)(r0 + ai * HALF + m * 16) * DM + col0 + bj * HALF + n * 16;
                        const f32x4 xv = *(const f32x4*)(xi + off); *(f32x4*)(xo + off) = xv + gv * acc[ai][bj][m][n]; } }
    }
};

struct CtxSplitOrder {
    int c; unsigned kq_bytes;
    __device__ bool next(int i, Unit& u) const { if (i != 0 || c >= 128) return false; const int t = c >> 2; u.pm = t & 3; u.pn = t >> 2; u.koff = (unsigned)(c & 3) * kq_bytes; return true; }
    __device__ __forceinline__ void a_ready(const Unit&) const {}
    __device__ __forceinline__ void done(const Unit&) const {}
};
struct EpiResidAtomic {
    static constexpr bool PERM = false, AFTER_DRAIN = false;
    float* xc; const float* gate; float gs;
    __device__ __forceinline__ void operator()(const f32x4 (&acc)[2][2][4][2], const Unit& u, int wr, int wc, int fr, int fq) const {
        float* xo = xc + (size_t)u.pm * BM * DM;
        const int r0 = wr * 64 + fr, col0 = u.pn * BM + wc * 32 + 4 * fq;
        const float* gp = gate + col0;
#pragma unroll
        for (int bj = 0; bj < 2; ++bj)
#pragma unroll
            for (int n = 0; n < 2; ++n) { const f32x4 gv = *(const f32x4*)(gp + bj * HALF + n * 16) * gs;
#pragma unroll
                for (int ai = 0; ai < 2; ++ai)
#pragma unroll
                    for (int m = 0; m < 4; ++m) { float* p = xo + (size_t)(r0 + ai * HALF + m * 16) * DM + col0 + bj * HALF + n * 16; const f32x4 v = gv * acc[ai][bj][m][n];
                        unsafeAtomicAdd(p, v[0]); unsafeAtomicAdd(p + 1, v[1]); unsafeAtomicAdd(p + 2, v[2]); unsafeAtomicAdd(p + 3, v[3]); } }
    }
};

template <class Epi, class Sched, bool ALIGN_EPI = false, bool SP2 = false>
__device__ __forceinline__ void gemm_phase(LAS unsigned char* lds, const Gemm g, const Sched& S, const Epi& E) {
    int tid = threadIdx.x; asm volatile("" : "+v"(tid));
    const int wid = __builtin_amdgcn_readfirstlane(tid >> 6), lane = tid & 63, wr = wid >> 2, wc = wid & 3, fr = lane & 15, fq = lane >> 4;
    const int K = g.ld, nt = g.K / BK;
    unsigned voffA[2], voffB[2];
#pragma unroll
    for (int i = 0; i < 2; ++i) { int R, C; stage_rc(tid * 16 + i * 8192, R, C); const int Rb = Epi::PERM ? ((R & ~31) + perm32(R & 31)) : R;
        voffA[i] = (unsigned)(R * K + C) * 2u; voffB[i] = (unsigned)(Rb * K + C) * 2u; }
    const size_t kstep = (size_t)(BK * 2);
    const size_t hstep = (size_t)HALF * K * 2;
    const size_t tstep = 2 * hstep;
    const unsigned ldsw = (unsigned)wid * 1024u;
    const int aoff = lds_byte(wr * 64 + fr, fq * 8), boff = lds_byte(wc * 32 + fr, fq * 8);
#define PG8_SA(b, h) (((b) * 2 + (h)) * HTB)
#define PG8_SB(b, h) ((4 + (b) * 2 + (h)) * HTB)
#define PG8_STAGE(bufoff, gbase, voff) do { _Pragma("unroll") for (int _i = 0; _i < 2; ++_i) \
        __builtin_amdgcn_global_load_lds((const unsigned*)((const char*)(gbase) + (voff)[_i]), (LAS unsigned*)(lds + (bufoff) + ldsw + _i * 8192), 16, 0, 0); } while (0)
#define PG8_LDA(dst, b, h) do { _Pragma("unroll") for (int m = 0; m < 4; ++m) _Pragma("unroll") for (int k = 0; k < 2; ++k) dst[m][k] = *(const LAS bf16x8*)(lds + PG8_SA(b, h) + aoff + m * 2048 + k * 1024); } while (0)
#define PG8_LDB(dst, b, h) do { _Pragma("unroll") for (int n = 0; n < 2; ++n) _Pragma("unroll") for (int k = 0; k < 2; ++k) dst[n][k] = *(const LAS bf16x8*)(lds + PG8_SB(b, h) + boff + n * 2048 + k * 1024); } while (0)
#define PG8_MMA(ai, bj, At, Bt) do { __builtin_amdgcn_s_setprio(1); _Pragma("unroll") for (int m = 0; m < 4; ++m) _Pragma("unroll") for (int n = 0; n < 2; ++n) _Pragma("unroll") for (int k = 0; k < 2; ++k) \
        acc[ai][bj][m][n] = __builtin_amdgcn_mfma_f32_16x16x32_bf16(Bt[n][k], At[m][k], acc[ai][bj][m][n], 0, 0, 0); __builtin_amdgcn_s_setprio(0); } while (0)
#define PG8_WAIT_V(n) asm volatile("s_waitcnt vmcnt(" #n ")" ::: "memory")
#define PG8_WAIT_L(n) asm volatile("s_waitcnt lgkmcnt(" #n ")" ::: "memory")
#define PG8_BAR __builtin_amdgcn_s_barrier()
#define PG8_SCHED __builtin_amdgcn_sched_barrier(0)
    Unit cur, nxt; int ui = 0;
    if (!S.next(0, cur)) return;
    f32x4 acc[2][2][4][2];
#pragma unroll
    for (int a = 0; a < 2; ++a)
#pragma unroll
        for (int b = 0; b < 2; ++b)
#pragma unroll
            for (int m = 0; m < 4; ++m)
#pragma unroll
                for (int n = 0; n < 2; ++n) acc[a][b][m][n] = (f32x4){0.f, 0.f, 0.f, 0.f};
    bf16x8 At[4][2], B0[2][2], B1[2][2];
    const char* cA = (const char*)g.A + (size_t)cur.pm * tstep + cur.koff; const char* cB = (const char*)g.Bt + (size_t)cur.pn * tstep + cur.koff;
    S.a_ready(cur);
    if constexpr (SP2) {
        PG8_STAGE(PG8_SB(0, 0), cB, voffB); PG8_STAGE(PG8_SB(0, 1), cB + hstep, voffB); PG8_STAGE(PG8_SA(0, 0), cA, voffA); PG8_STAGE(PG8_SA(0, 1), cA + hstep, voffA);
        if (wr == 1) PG8_BAR;
        PG8_WAIT_V(2); PG8_BAR;
        PG8_STAGE(PG8_SB(1, 0), cB + kstep, voffB); PG8_STAGE(PG8_SA(1, 0), cA + kstep, voffA); PG8_STAGE(PG8_SB(1, 1), cB + hstep + kstep, voffB);
        PG8_WAIT_V(6); PG8_BAR;
    } else {
        PG8_STAGE(PG8_SB(0, 0), cB, voffB); PG8_STAGE(PG8_SA(0, 0), cA, voffA); PG8_STAGE(PG8_SB(0, 1), cB + hstep, voffB); PG8_STAGE(PG8_SA(0, 1), cA + hstep, voffA);
        if (wr == 1) PG8_BAR;
        PG8_WAIT_V(4); PG8_BAR;
        PG8_STAGE(PG8_SB(1, 0), cB + kstep, voffB); PG8_STAGE(PG8_SA(1, 0), cA + kstep, voffA); PG8_STAGE(PG8_SB(1, 1), cB + hstep + kstep, voffB);
        PG8_WAIT_V(6); PG8_BAR;
    }
    for (;;) {
        const bool has_next = S.next(ui + 1, nxt);
        const char* nA = has_next ? (const char*)g.A + (size_t)nxt.pm * tstep + nxt.koff : cA; const char* nB = has_next ? (const char*)g.Bt + (size_t)nxt.pn * tstep + nxt.koff : cB;
        for (int t = 0; t < nt; t += 2) {
            const bool last = (t == nt - 2);
            const char* a1 = cA + (size_t)(t + 1) * kstep;
            const char* a2 = last ? nA : cA + (size_t)(t + 2) * kstep; const char* b2 = last ? nB : cB + (size_t)(t + 2) * kstep;
            const char* a3 = a2 + kstep; const char* b3 = b2 + kstep;
            if (last && has_next) S.a_ready(nxt);
            if constexpr (SP2) {
            PG8_LDB(B0, 0, 0); PG8_LDB(B1, 0, 1); PG8_SCHED; PG8_LDA(At, 0, 0); PG8_STAGE(PG8_SA(1, 1), a1 + hstep, voffA);
            PG8_WAIT_V(8); PG8_WAIT_L(0); PG8_BAR; PG8_MMA(0, 0, At, B0); PG8_MMA(0, 1, At, B1); PG8_BAR; PG8_SCHED;
            PG8_LDA(At, 0, 1); PG8_STAGE(PG8_SB(0, 0), b2, voffB); PG8_STAGE(PG8_SB(0, 1), b2 + hstep, voffB); PG8_STAGE(PG8_SA(0, 0), a2, voffA);
            PG8_WAIT_V(8); PG8_WAIT_L(0); PG8_BAR; PG8_MMA(1, 0, At, B0); PG8_MMA(1, 1, At, B1); PG8_BAR; PG8_SCHED;
            PG8_LDB(B0, 1, 0); PG8_LDB(B1, 1, 1); PG8_SCHED; PG8_LDA(At, 1, 0); PG8_STAGE(PG8_SA(0, 1), a2 + hstep, voffA);
            PG8_WAIT_V(8); PG8_WAIT_L(0); PG8_BAR; PG8_MMA(0, 0, At, B0); PG8_MMA(0, 1, At, B1); PG8_BAR; PG8_SCHED;
            PG8_LDA(At, 1, 1); PG8_STAGE(PG8_SB(1, 0), b3, voffB); PG8_STAGE(PG8_SB(1, 1), b3 + hstep, voffB); PG8_STAGE(PG8_SA(1, 0), a3, voffA);
            PG8_WAIT_V(8); PG8_WAIT_L(0); PG8_BAR; PG8_MMA(1, 0, At, B0); PG8_MMA(1, 1, At, B1); PG8_BAR; PG8_SCHED;
            } else {
            PG8_LDB(B0, 0, 0); PG8_SCHED; PG8_LDA(At, 0, 0); PG8_STAGE(PG8_SA(1, 1), a1 + hstep, voffA);
            PG8_WAIT_L(8); PG8_BAR; PG8_WAIT_L(0); PG8_MMA(0, 0, At, B0); PG8_BAR; PG8_SCHED;
            PG8_LDB(B1, 0, 1); PG8_STAGE(PG8_SB(0, 0), b2, voffB);
            PG8_BAR; PG8_WAIT_L(0); PG8_MMA(0, 1, At, B1); PG8_BAR;
            PG8_LDA(At, 0, 1); PG8_STAGE(PG8_SA(0, 0), a2, voffA);
            PG8_BAR; PG8_WAIT_L(0); PG8_MMA(1, 0, At, B0); PG8_BAR; PG8_SCHED;
            PG8_STAGE(PG8_SB(0, 1), b2 + hstep, voffB);
            PG8_WAIT_V(6); PG8_BAR; PG8_MMA(1, 1, At, B1); PG8_BAR;
            PG8_LDB(B0, 1, 0); PG8_SCHED; PG8_LDA(At, 1, 0); PG8_STAGE(PG8_SA(0, 1), a2 + hstep, voffA);
            PG8_WAIT_L(8); PG8_BAR; PG8_WAIT_L(0); PG8_MMA(0, 0, At, B0); PG8_BAR; PG8_SCHED;
            PG8_LDB(B1, 1, 1); PG8_STAGE(PG8_SB(1, 0), b3, voffB);
            PG8_BAR; PG8_WAIT_L(0); PG8_MMA(0, 1, At, B1); PG8_BAR;
            PG8_LDA(At, 1, 1); PG8_STAGE(PG8_SA(1, 0), a3, voffA);
            PG8_BAR; PG8_WAIT_L(0); PG8_MMA(1, 0, At, B0); PG8_BAR; PG8_SCHED;
            PG8_STAGE(PG8_SB(1, 1), b3 + hstep, voffB);
            PG8_WAIT_V(6); PG8_BAR; PG8_MMA(1, 1, At, B1); PG8_BAR;
            }
        }
        if constexpr (ALIGN_EPI) { if (wr == 0) PG8_BAR; }
        if constexpr (!Epi::AFTER_DRAIN) { E(acc, cur, wr, wc, fr, fq); S.done(cur); }
        if (!has_next) break;
#pragma unroll
        for (int a = 0; a < 2; ++a)
#pragma unroll
            for (int b = 0; b < 2; ++b)
#pragma unroll
                for (int m = 0; m < 4; ++m)
#pragma unroll
                    for (int n = 0; n < 2; ++n) acc[a][b][m][n] = (f32x4){0.f, 0.f, 0.f, 0.f};
        cur = nxt; cA = nA; cB = nB; ++ui;
        if constexpr (ALIGN_EPI) { if (wr == 1) PG8_BAR; }
    }
    PG8_WAIT_V(0);
    if constexpr (!ALIGN_EPI) { if (wr == 0) PG8_BAR; }
    PG8_BAR;
#undef PG8_SA
#undef PG8_SB
#undef PG8_STAGE
#undef PG8_LDA
#undef PG8_LDB
#undef PG8_MMA
#undef PG8_WAIT_V
#undef PG8_WAIT_L
#undef PG8_BAR
#undef PG8_SCHED
}
}

namespace att {
constexpr int SHM_V = 64 * 128 * 2, SHM_K = SHM_V;
constexpr int OFF_V = 0, OFF_K = 2 * SHM_V, OFF_WS = 4 * SHM_V, OFF_OST = OFF_WS + 2048, OST_WAVE = 32 * 272, OFF_RPB = OFF_OST + 8 * OST_WAVE, ATT_LDS_END = OFF_RPB + 2048;
static_assert(ATT_LDS_END <= LDSCTL_OFF, "attention LDS map");
constexpr float THR = 11.5f;
#define KSWZ(row, colB) ((row) * 256 + ((colB) ^ (((row) & 7) << 4)))
#define SBAR() __builtin_amdgcn_sched_barrier(0)
__device__ __forceinline__ int crow(int r, int hi) { return (r & 3) + 8 * (r >> 2) + 4 * hi; }
__device__ __forceinline__ void partialSM(f32x16& p0, f32x16& p1, float& m_reg, float& mn, float& alpha) {
    float pmax = p0[0];
#pragma unroll
    for (int r = 1; r < 16; ++r) pmax = fmaxf(pmax, p0[r]);
#pragma unroll
    for (int r = 0; r < 16; ++r) pmax = fmaxf(pmax, p1[r]);
    { auto rr = __builtin_amdgcn_permlane32_swap(__float_as_uint(pmax), __float_as_uint(pmax), false, false);
      pmax = fmaxf(__uint_as_float(rr[0]), __uint_as_float(rr[1])); }
    if (__builtin_expect(__all(pmax - m_reg <= THR), 1)) { mn = m_reg; alpha = 1.f; }
    else { mn = fmaxf(m_reg, pmax); alpha = __builtin_amdgcn_exp2f(m_reg - mn); m_reg = mn; }
#pragma unroll
    for (int r = 0; r < 16; ++r) p0[r] = p0[r] - mn;
#pragma unroll
    for (int r = 0; r < 16; ++r) p1[r] = p1[r] - mn;
#pragma unroll
    for (int r = 0; r < 16; ++r) p0[r] = __builtin_amdgcn_exp2f(p0[r]);
}
__device__ __forceinline__ void finishSM(f32x16& p0, f32x16& p1, float alpha, float& l_reg, bf16x8& pa0, bf16x8& pa1, bf16x8& pa2, bf16x8& pa3) {
#pragma unroll
    for (int r = 0; r < 16; ++r) p1[r] = __builtin_amdgcn_exp2f(p1[r]);
    float ps = 0;
#pragma unroll
    for (int r = 0; r < 16; ++r) ps += p0[r];
#pragma unroll
    for (int r = 0; r < 16; ++r) ps += p1[r];
    { auto rr = __builtin_amdgcn_permlane32_swap(__float_as_uint(ps), __float_as_uint(ps), false, false);
      ps = __uint_as_float(rr[0]) + __uint_as_float(rr[1]); }
    l_reg = l_reg * alpha + ps;
#define PK4(P, BASE, OUT) do { unsigned a0 = cvt_pk_bf16(P[BASE + 0], P[BASE + 1]), a1 = cvt_pk_bf16(P[BASE + 2], P[BASE + 3]);   \
    unsigned b0 = cvt_pk_bf16(P[BASE + 4], P[BASE + 5]), b1 = cvt_pk_bf16(P[BASE + 6], P[BASE + 7]);                              \
    auto r0 = __builtin_amdgcn_permlane32_swap(a0, b0, false, false); auto r1 = __builtin_amdgcn_permlane32_swap(a1, b1, false, false); \
    u32x4 w = {r0[0], r1[0], r0[1], r1[1]}; OUT = __builtin_bit_cast(bf16x8, w); } while (0)
    PK4(p0, 0, pa0); PK4(p0, 8, pa1); PK4(p1, 0, pa2); PK4(p1, 8, pa3);
#undef PK4
}
__device__ __forceinline__ void qkt(f32x16& p0, f32x16& p1, const LAS char* Ks, const bf16x8* qr, int r32, int hi) {
    p0 = f32x16{}; p1 = f32x16{};
#pragma unroll
    for (int d0 = 0; d0 < 8; ++d0) { const int cb = (d0 * 16 + hi * 8) * 2;
        const bf16x8 b0 = *(const LAS bf16x8*)(Ks + KSWZ(r32, cb));
        const bf16x8 b1 = *(const LAS bf16x8*)(Ks + KSWZ(32 + r32, cb));
        p0 = __builtin_amdgcn_mfma_f32_32x32x16_bf16(b0, qr[d0], p0, 0, 0, 0);
        p1 = __builtin_amdgcn_mfma_f32_32x32x16_bf16(b1, qr[d0], p1, 0, 0, 0); }
}
__device__ __forceinline__ int v_st(int k, int c) { const int kk = (k & ~0xC) | ((k & 4) << 1) | ((k & 8) >> 1); return ((kk >> 3) * 4 + (c >> 5)) * 512 + ((kk & 7) * 32 + (c & 31)) * 2; }
__device__ __forceinline__ int v_rd_base(int lane) { return ((lane & 3) << 3) | (((lane >> 2) & 3) << 6) | (((lane >> 4) & 1) << 5) | (((lane >> 5) & 1) << 8); }
constexpr int v_rd_off(int d0, int ks, int half) { return d0 * 512 + ks * 4096 + half * 2048; }
template <int OFF> __device__ __forceinline__ s16x4 tr_read(int vb) {
    s16x4 r; asm volatile("ds_read_b64_tr_b16 %0, %1 offset:%2" : "=&v"(r) : "v"(vb), "i"(OFF) : "memory"); return r;
}
template <int D0> __device__ __forceinline__ void pv_one(f32x16& od, int vb, bf16x8 pa0, bf16x8 pa1, bf16x8 pa2, bf16x8 pa3) {
    const s16x4 l0 = tr_read<v_rd_off(D0, 0, 0)>(vb), h0 = tr_read<v_rd_off(D0, 0, 1)>(vb), l1 = tr_read<v_rd_off(D0, 1, 0)>(vb), h1 = tr_read<v_rd_off(D0, 1, 1)>(vb);
    const s16x4 l2 = tr_read<v_rd_off(D0, 2, 0)>(vb), h2 = tr_read<v_rd_off(D0, 2, 1)>(vb), l3 = tr_read<v_rd_off(D0, 3, 0)>(vb), h3 = tr_read<v_rd_off(D0, 3, 1)>(vb);
    asm volatile("s_waitcnt lgkmcnt(0)" ::: "memory"); SBAR();
#define PK(L, H) (bf16x8){L[0], L[1], L[2], L[3], H[0], H[1], H[2], H[3]}
    od = __builtin_amdgcn_mfma_f32_32x32x16_bf16(pa0, PK(l0, h0), od, 0, 0, 0);
    od = __builtin_amdgcn_mfma_f32_32x32x16_bf16(pa1, PK(l1, h1), od, 0, 0, 0);
    od = __builtin_amdgcn_mfma_f32_32x32x16_bf16(pa2, PK(l2, h2), od, 0, 0, 0);
    od = __builtin_amdgcn_mfma_f32_32x32x16_bf16(pa3, PK(l3, h3), od, 0, 0, 0);
#undef PK
}
__device__ __forceinline__ void pv_d0(f32x16* o, int vb, bf16x8 pa0, bf16x8 pa1, bf16x8 pa2, bf16x8 pa3) {
    pv_one<0>(o[0], vb, pa0, pa1, pa2, pa3); pv_one<1>(o[1], vb, pa0, pa1, pa2, pa3); pv_one<2>(o[2], vb, pa0, pa1, pa2, pa3); pv_one<3>(o[3], vb, pa0, pa1, pa2, pa3);
}

struct Mask { int kind, nb, jlo, pq  , rk0, qr, qc  ; const LAS float* rpb; };
__device__ __forceinline__ void apply_mask(f32x16& p0, f32x16& p1, const Mask& M, int t, int hi) {
    if (t >= M.nb) return;
    const float NEG = -__builtin_inff();
#define CR(r) (((r) & 3) + 8 * ((r) >> 2))
    if (M.kind == 0) {
        const int jt = M.jlo + t;
        if (jt < 2) { const int lim = M.pq - 64 * jt - 4 * hi;
#pragma unroll
            for (int r = 0; r < 16; ++r) { p0[r] = (CR(r) >= lim) ? p0[r] : NEG; p1[r] = (CR(r) + 32 >= lim) ? p1[r] : NEG; }
        } else if (jt >= 4) { const int lim = M.pq - 64 * (jt - 4) - 4 * hi;
#pragma unroll
            for (int r = 0; r < 16; ++r) { p0[r] = (CR(r) <= lim) ? p0[r] : NEG; p1[r] = (CR(r) + 32 <= lim) ? p1[r] : NEG; }
        }
    } else if (M.kind == 1) {
        const int kr = M.rk0 + t; int r0q = M.qr - 4; r0q = r0q < 0 ? 0 : (r0q > 120 ? 120 : r0q);
        const bool rowok = (kr >= r0q) && (kr < r0q + 8);
        int dr = kr - M.qr + 7; dr = dr < 0 ? 0 : (dr > 14 ? 14 : dr);
        int c0 = M.qc - 8; c0 = c0 < 0 ? 0 : (c0 > 48 ? 48 : c0);
        const int c0h = rowok ? (c0 - 4 * hi) : 1000;
        const LAS float* tb = M.rpb + dr * 31 + (15 - M.qc) + 4 * hi;
#pragma unroll
        for (int r = 0; r < 16; ++r) { const float b0 = tb[CR(r)]; p0[r] = ((unsigned)(CR(r) - c0h) < 16u) ? p0[r] + b0 : NEG; }
        SBAR();
#pragma unroll
        for (int r = 0; r < 16; ++r) { const float b1 = tb[CR(r) + 32]; p1[r] = ((unsigned)(CR(r) + 32 - c0h) < 16u) ? p1[r] + b1 : NEG; }
    }
#undef CR
}

__device__ __forceinline__ void attn_unit(const bf16_t* __restrict__ P, bf16_t* __restrict__ MIX, const float* __restrict__ sinkp, const float* __restrict__ rpbp,
                                          int kind, int b, int i1, int i2, LAS char* lds) {
    int tid = threadIdx.x; asm volatile("" : "+v"(tid));
    const int wid = __builtin_amdgcn_readfirstlane(tid >> 6), lane = tid & 63, r32 = lane & 31, hi = lane >> 5;
    LAS char* V_lds = lds + OFF_V; LAS char* K_lds = lds + OFF_K;
    LAS float* wsf = (LAS float*)(lds + OFF_WS) + wid * 64; LAS float* li_l = wsf; LAS float* al_l = wsf + 32;
    LAS float* rpb_l = (LAS float*)(lds + OFF_RPB);
    int qbase, qcol, ocol, nb, row0, kcol, vcol; float sink2 = -__builtin_inff();
    Mask MK; MK.kind = kind; MK.jlo = 0; MK.pq = 0; MK.rk0 = 0; MK.qr = 0; MK.qc = 0; MK.rpb = rpb_l;
    if (kind == 0) {
        const int n = i1, kvh = i2 >> 1, gp = i2 & 1, g = 2 * gp + (wid >> 2), qh = 4 * kvh + g, p0q = 32 * (wid & 3);
        qbase = b * SEQ + n * 128 + p0q; qcol = PC_WQ + qh * 128; ocol = 1024 + qh * 128;
        const int jlo = (n == 0) ? 2 : 0, jhi = (n == SEQ / 128 - 1) ? 4 : 6; nb = jhi - jlo; row0 = b * SEQ + (n - 1) * 128 + 64 * jlo;
        kcol = PC_WK + kvh * 128; vcol = PC_WV + kvh * 128; sink2 = sinkp[qh] * LOG2E;
        MK.jlo = jlo; MK.pq = p0q + r32;
    } else if (kind == 1) {
        const int r = 4 * i1, h = i2, qr = r + (wid >> 1), c32 = 32 * (wid & 1);
        qbase = b * SEQ + qr * 64 + c32; qcol = PC_NQ + h * 128; ocol = h * 128;
        int rk0 = r - 4; rk0 = rk0 < 0 ? 0 : (rk0 > 116 ? 116 : rk0); nb = 12; row0 = b * SEQ + rk0 * 64;
        kcol = PC_NK + h * 128; vcol = PC_NV + h * 128;
        MK.rk0 = rk0; MK.qr = qr; MK.qc = c32 + r32;
        if (tid < 15 * 31) rpb_l[tid] = rpbp[h * (15 * 31) + tid] * LOG2E;
    } else if (kind == 2) {
        const int h = i1; qbase = ML + b * NCTX + 32 * wid; qcol = PC_NQ + h * 128; ocol = h * 128; nb = 0; row0 = 0; kcol = PC_NK + h * 128; vcol = PC_NV + h * 128;
    } else {
        const int qh = i1, kvh = qh >> 2; qbase = ML + b * NCTX + 32 * wid; qcol = PC_WQ + qh * 128; ocol = 1024 + qh * 128; nb = 0; row0 = 0;
        kcol = PC_WK + kvh * 128; vcol = PC_WV + kvh * 128; sink2 = sinkp[qh] * LOG2E;
    }
    MK.nb = nb;
    const int crow0 = ML + b * NCTX, NT = nb + 4;
    float m_reg = -1e30f, l_reg = 0; f32x16 o[4] = {}; bf16x8 qr[8];
    { const bf16_t* Qw = P + (size_t)(qbase + r32) * INW + qcol + hi * 8;
#pragma unroll
      for (int d0 = 0; d0 < 8; ++d0) qr[d0] = *(const bf16x8*)(Qw + d0 * 16); }
    const int sr = tid >> 4, sc = (tid & 15) * 8, vst0 = v_st(sr, sc), vst1 = v_st(32 + sr, sc);
    const int vb0 = (int)(unsigned)(size_t)V_lds + v_rd_base(lane);
#define TROW(t) (((t) < nb) ? (row0 + 64 * (t)) : (crow0 + 64 * ((t) - nb)))
#define RESC(a) do { if (__any((a) < 1.f)) { if (hi == 0) al_l[r32] = (a); asm volatile("s_waitcnt lgkmcnt(0)" ::: "memory"); \
    _Pragma("unroll") for (int d = 0; d < 4; ++d) _Pragma("unroll") for (int r = 0; r < 16; ++r) o[d][r] *= al_l[crow(r, hi)]; } } while (0)
#if ATT_PIPE2
    struct { bf16x8 vs0, vs1, ks0, ks1; } sr_[2];
#define SLOAD(i, t) do { const bf16_t* _b = P + (size_t)(TROW(t) + sr) * INW + sc; \
    sr_[i].vs0 = *(const bf16x8*)(_b + vcol); sr_[i].vs1 = *(const bf16x8*)(_b + (size_t)32 * INW + vcol); \
    sr_[i].ks0 = *(const bf16x8*)(_b + kcol); sr_[i].ks1 = *(const bf16x8*)(_b + (size_t)32 * INW + kcol); } while (0)
#define SWRITE(bb, i) do { *(LAS bf16x8*)(V_lds + (bb) * SHM_V + vst0) = sr_[i].vs0; *(LAS bf16x8*)(V_lds + (bb) * SHM_V + vst1) = sr_[i].vs1; const int kc_ = sc * 2; \
    *(LAS bf16x8*)(K_lds + (bb) * SHM_K + KSWZ(sr, kc_)) = sr_[i].ks0; *(LAS bf16x8*)(K_lds + (bb) * SHM_K + KSWZ(32 + sr, kc_)) = sr_[i].ks1; } while (0)
#define SWAIT() asm volatile("s_waitcnt vmcnt(4)" ::: "memory")
    f32x16 pA0, pA1, pB0, pB1; float mnA, mnB, alA, alB; bf16x8 pa0, pa1, pa2, pa3;
    constexpr int SE = 0, SO = 1;
    SLOAD(SE, 0); asm volatile("s_waitcnt vmcnt(0)" ::: "memory"); SWRITE(0, SE); __syncthreads();
    qkt(pA0, pA1, K_lds, qr, r32, hi); apply_mask(pA0, pA1, MK, 0, hi); partialSM(pA0, pA1, m_reg, mnA, alA);
    SLOAD(SO, 1); if (2 < NT) SLOAD(SE, 2);
    SWAIT(); SWRITE(1, SO); __syncthreads();
    for (int j = 1; j + 1 < NT; j += 2) {
        SBAR(); qkt(pB0, pB1, K_lds + SHM_K, qr, r32, hi);
        finishSM(pA0, pA1, alA, l_reg, pa0, pa1, pa2, pa3); SBAR();
        SLOAD(SO, j + 2); SBAR();
        pv_d0(o, vb0, pa0, pa1, pa2, pa3); apply_mask(pB0, pB1, MK, j, hi); partialSM(pB0, pB1, m_reg, mnB, alB);
        __syncthreads(); SWAIT(); SWRITE(0, SE);
        RESC(alB); __syncthreads();
        SBAR(); qkt(pA0, pA1, K_lds, qr, r32, hi);
        finishSM(pB0, pB1, alB, l_reg, pa0, pa1, pa2, pa3); SBAR();
        if (j + 3 < NT) SLOAD(SE, j + 3); SBAR();
        pv_d0(o, vb0 + SHM_V, pa0, pa1, pa2, pa3); apply_mask(pA0, pA1, MK, j + 1, hi); partialSM(pA0, pA1, m_reg, mnA, alA);
        __syncthreads(); SWAIT(); SWRITE(1, SO);
        RESC(alA); __syncthreads();
    }
    SBAR(); qkt(pB0, pB1, K_lds + SHM_K, qr, r32, hi);
    finishSM(pA0, pA1, alA, l_reg, pa0, pa1, pa2, pa3); SBAR();
    pv_d0(o, vb0, pa0, pa1, pa2, pa3); apply_mask(pB0, pB1, MK, NT - 1, hi); partialSM(pB0, pB1, m_reg, mnB, alB);
    __syncthreads(); RESC(alB);
    finishSM(pB0, pB1, alB, l_reg, pa0, pa1, pa2, pa3); SBAR();
    pv_d0(o, vb0 + SHM_V, pa0, pa1, pa2, pa3);
#undef SWAIT
#else
    bf16x8 vs0, vs1, ks0, ks1;
#define SLOAD(t) do { const bf16_t* _b = P + (size_t)(TROW(t) + sr) * INW + sc; \
    vs0 = *(const bf16x8*)(_b + vcol); vs1 = *(const bf16x8*)(_b + (size_t)32 * INW + vcol); \
    ks0 = *(const bf16x8*)(_b + kcol); ks1 = *(const bf16x8*)(_b + (size_t)32 * INW + kcol); } while (0)
#define SWRITE(bb) do { *(LAS bf16x8*)(V_lds + (bb) * SHM_V + vst0) = vs0; *(LAS bf16x8*)(V_lds + (bb) * SHM_V + vst1) = vs1; const int kc_ = sc * 2; \
    *(LAS bf16x8*)(K_lds + (bb) * SHM_K + KSWZ(sr, kc_)) = ks0; *(LAS bf16x8*)(K_lds + (bb) * SHM_K + KSWZ(32 + sr, kc_)) = ks1; } while (0)
    SLOAD(0); asm volatile("s_waitcnt vmcnt(0)" ::: "memory"); SWRITE(0); SLOAD(1); __syncthreads();
    for (int j = 0; j < NT; ++j) {
        const int bsel = j & 1;
        f32x16 p0, p1; float mn, al; bf16x8 pa0, pa1, pa2, pa3;
        qkt(p0, p1, K_lds + bsel * SHM_K, qr, r32, hi);
        apply_mask(p0, p1, MK, j, hi);
        partialSM(p0, p1, m_reg, mn, al);
        RESC(al);
        finishSM(p0, p1, al, l_reg, pa0, pa1, pa2, pa3);
        pv_d0(o, vb0 + bsel * SHM_V, pa0, pa1, pa2, pa3);
        if (j + 1 < NT) { asm volatile("s_waitcnt vmcnt(0)" ::: "memory"); SWRITE(bsel ^ 1); if (j + 2 < NT) SLOAD(j + 2); }
        __syncthreads();
    }
#endif
    l_reg += __builtin_amdgcn_exp2f(sink2 - m_reg);
    if (hi == 0) li_l[r32] = l_reg; asm volatile("s_waitcnt lgkmcnt(0)" ::: "memory");
    LAS char* ost = lds + OFF_OST + wid * OST_WAVE;
#pragma unroll
    for (int r = 0; r < 16; ++r) { const int orow = crow(r, hi); const float rl = __builtin_amdgcn_rcpf(li_l[orow]);
#pragma unroll
        for (int d0 = 0; d0 < 4; ++d0) *(LAS unsigned short*)(ost + orow * 272 + (d0 * 32 + r32) * 2) = (unsigned short)f2bf(o[d0][r] * rl); }
    asm volatile("s_waitcnt lgkmcnt(0)" ::: "memory");
#pragma unroll
    for (int i = 0; i < 8; ++i) { const int id = i * 64 + lane, rr = id >> 4, c16 = id & 15;
        const u32x4 v = *(const LAS u32x4*)(ost + rr * 272 + c16 * 16);
        *(u32x4*)(MIX + (size_t)(qbase + rr) * DM + ocol + c16 * 8) = v; }
#undef TROW
#undef SLOAD
#undef SWRITE
#undef RESC
}
}

#define XB_TMO      128
#define XB_XCNT(j)  (256  + 64 * (j))
#define XB_XSUB(j)  (1280 + 64 * (j))
#define XB_XGEN(j)  (2304 + 64 * (j))
#define XB_TOP      3328
#define XB_TOPGEN   3392
#define XCD_BAR_WORDS 3456
#define XB_SPIN_CAP (1u << 18)
__device__ __forceinline__ unsigned xb_ld(unsigned* p)              { return __hip_atomic_load(p, __ATOMIC_RELAXED, __HIP_MEMORY_SCOPE_AGENT); }
__device__ __forceinline__ unsigned xb_add(unsigned* p, unsigned v) { return __hip_atomic_fetch_add(p, v, __ATOMIC_RELAXED, __HIP_MEMORY_SCOPE_AGENT); }
__device__ __forceinline__ unsigned xb_xcc_id() { return (unsigned)__builtin_amdgcn_s_getreg((3 << 11) | 20) & 0xFu; }
#define XB_SPIN(cond, bar) do { unsigned _sp = 0; while (cond) { __builtin_amdgcn_s_sleep(1); \
    if ((++_sp & 255u) == 0u) { if (xb_ld(&(bar)[XB_TMO])) break; if (_sp > XB_SPIN_CAP) { atomicAdd(&(bar)[XB_TMO], 1u); break; } } } } while (0)
struct XcdBarrier { unsigned* bar; unsigned x; volatile LAS unsigned* st; };
__device__ __forceinline__ XcdBarrier xcd_barrier_post(unsigned* bar, volatile LAS unsigned* st) {
    XcdBarrier b; b.bar = bar; b.x = xb_xcc_id(); b.st = st;
    if (threadIdx.x == 0) (void)xb_add(&bar[XB_XCNT(b.x)], 1u);
    return b;
}
__device__ __forceinline__ void xcd_barrier_complete(unsigned* bar, unsigned x, unsigned& nloc, unsigned& nx) {
    const unsigned G = gridDim.x * gridDim.y * gridDim.z;
    unsigned sum, cnt, mine, sp = 0u;
    for (;;) {
        sum = 0u; cnt = 0u; mine = 0u;
#pragma unroll
        for (unsigned j = 0; j < 16; ++j) { const unsigned c = xb_ld(&bar[XB_XCNT(j)]); sum += c; cnt += (c > 0u) ? 1u : 0u; mine = (j == x) ? c : mine; }
        if (sum == G) break;
        __builtin_amdgcn_s_sleep(1);
        if ((++sp & 255u) == 0u) { if (xb_ld(&bar[XB_TMO])) break; if (sp > XB_SPIN_CAP) { atomicAdd(&bar[XB_TMO], 1u); break; } }
    }
    nloc = mine > 0u ? mine : 1u; nx = cnt > 0u ? cnt : 1u;
}
__device__ __forceinline__ void xcd_barrier(const XcdBarrier& b) {
    asm volatile("s_waitcnt vmcnt(0)" ::: "memory");
    __syncthreads();
    if (threadIdx.x == 0) {
        unsigned* bar = b.bar;
        __builtin_amdgcn_s_waitcnt(0);
        unsigned nloc = b.st[0], nx = b.st[1];
        if (nloc == 0u) { xcd_barrier_complete(bar, b.x, nloc, nx); b.st[0] = nloc; b.st[1] = nx; }
        const unsigned old = xb_add(&bar[XB_XSUB(b.x)], 1u);
        const unsigned gen = old / nloc;
        if (old + 1u == (gen + 1u) * nloc) {
            __builtin_amdgcn_fence(__ATOMIC_RELEASE, "agent");
            asm volatile("s_waitcnt vmcnt(0)" ::: "memory");
            const unsigned og = xb_add(&bar[XB_TOP], 1u);
            const unsigned tg = og / nx;
            if (og + 1u == (tg + 1u) * nx) xb_add(&bar[XB_TOPGEN], 1u);
            else XB_SPIN(xb_ld(&bar[XB_TOPGEN]) == tg, bar);
            __builtin_amdgcn_fence(__ATOMIC_ACQUIRE, "agent");
            xb_add(&bar[XB_XGEN(b.x)], 1u);
            asm volatile("s_waitcnt vmcnt(0)" ::: "memory");
        } else {
            XB_SPIN(xb_ld(&bar[XB_XGEN(b.x)]) == gen, bar);
            __builtin_amdgcn_fence(__ATOMIC_ACQUIRE, "agent");
            asm volatile("s_waitcnt vmcnt(0)" ::: "memory");
        }
    }
    __syncthreads();
}

__device__ __forceinline__ int wt_dest_row(int n0, int N, bool swiglu) {
    if (!swiglu) return n0;
    const int half = N / 2; const int j = (n0 < half) ? n0 : n0 - half; return 256 * (j >> 7) + (j & 127) + ((n0 < half) ? 0 : 128);
}
__device__ __forceinline__ void transpose_item(const float* __restrict__ W, int K, int N, bf16_t* __restrict__ WT, bool swiglu, int item, int lane) {
    const int nblk = N / 64, kb = item / nblk, nbi = item - kb * nblk, k0 = 64 * kb, n0 = 64 * nbi;
    const int k8 = lane & 7, n4 = lane >> 3;
    const float* src = W + (size_t)(k0 + 8 * k8) * N + n0 + 4 * n4;
    f32x4 v[2][8];
#pragma unroll
    for (int h = 0; h < 2; ++h)
#pragma unroll
        for (int i = 0; i < 8; ++i) v[h][i] = __builtin_nontemporal_load((const f32x4*)(src + (size_t)i * N + 32 * h));
#pragma unroll
    for (int h = 0; h < 2; ++h) { const int d0 = wt_dest_row(n0 + 32 * h, N, swiglu);
        bf16_t* dst = WT + (size_t)(d0 + 4 * n4) * K + k0 + 8 * k8;
#pragma unroll
        for (int j = 0; j < 4; ++j) { u32x4 o; o.x = cvt_pk_bf16(v[h][0][j], v[h][1][j]); o.y = cvt_pk_bf16(v[h][2][j], v[h][3][j]); o.z = cvt_pk_bf16(v[h][4][j], v[h][5][j]); o.w = cvt_pk_bf16(v[h][6][j], v[h][7][j]);
            *(u32x4*)(dst + (size_t)j * K) = o; } }
}
__device__ __forceinline__ float silu_f(float x) { return x / (1.0f + __expf(-x)); }
__device__ __forceinline__ void sincos_small(float a, float& c, float& s) {
    const float n = rintf(a * 0.63661977236758134f);
    float r = fmaf(-n, 1.57079637050628662109375f, a); r = fmaf(n, 4.37113900018624283e-8f, r);
    const float z = r * r;
    const float sp = r + r * z * (-1.6666654611e-1f + z * (8.3321608736e-3f + z * (-1.9515295891e-4f)));
    const float cp = 1.0f - 0.5f * z + z * z * (4.166664568298827e-2f + z * (-1.388731625493765e-3f + z * 2.443315711809948e-5f));
    const int q = ((int)n) & 3;
    c = (q == 0) ? cp : (q == 1) ? -sp : (q == 2) ? -cp : sp;
    s = (q == 0) ? sp : (q == 1) ? cp : (q == 2) ? -sp : -cp;
}

__device__ __forceinline__ void norm_phase(const float* xl, const float* xc, const float* g, const float* modl, int shift_chunk, int scale_chunk, bf16_t* H, int nrows, int gw, int ngw, int lane) {
    for (int row = gw; row < nrows; row += ngw) {
        const float* xr = (row < ML) ? xl + (size_t)row * DM : xc + (size_t)(row - ML) * DM;
        const int s = (row < ML) ? (row >> 13) : 4;
        const f32x4* sh = (const f32x4*)(modl + (size_t)s * MODW + shift_chunk * DM); const f32x4* scp = (const f32x4*)(modl + (size_t)s * MODW + scale_chunk * DM);
        f32x4 v[8]; float ss = 0.f;
#pragma unroll
        for (int j = 0; j < 8; ++j) { v[j] = ((const f32x4*)xr)[lane + 64 * j]; ss += (v[j].x * v[j].x + v[j].y * v[j].y) + (v[j].z * v[j].z + v[j].w * v[j].w); }
        const float rstd = 1.0f / sqrtf(wave_sum(ss) * (1.0f / DM) + 1e-6f);
        u32x2* o8 = (u32x2*)(H + (size_t)row * DM) + lane;
#pragma unroll
        for (int j = 0; j < 8; ++j) { const f32x4 gj = ((const f32x4*)g)[lane + 64 * j], sj = scp[lane + 64 * j], hj = sh[lane + 64 * j];
            const f32x4 y = v[j] * rstd * gj * (sj + 1.0f) + hj;
            u32x2 w; w.x = cvt_pk_bf16(y.x, y.y); w.y = cvt_pk_bf16(y.z, y.w); o8[64 * j] = w; }
    }
}

__device__ __forceinline__ void prep_phase(bf16_t* P, const float* na_gain, const float* wa_gain, const float* rope, int gthread, int nthreads) {
    const int sub = gthread & 15;
    for (int item = gthread >> 4; item < MT * 18; item += (nthreads >> 4)) {
        const int row = item / 18, hx = item - row * 18;
        int col; bool isq, iswa;
        if (hx < 4) { col = PC_NQ + 128 * hx; isq = true; iswa = false; }
        else if (hx < 8) { col = PC_NK + 128 * (hx - 4); isq = false; iswa = false; }
        else if (hx < 16) { col = PC_WQ + 128 * (hx - 8); isq = true; iswa = true; }
        else { col = PC_WK + 128 * (hx - 16); isq = false; iswa = true; }
        bf16_t* p = P + (size_t)row * INW + col + 8 * sub;
        const u32x4 raw = *(const u32x4*)p;
        float v[8];
        v[0] = __builtin_bit_cast(float, raw.x << 16); v[1] = __builtin_bit_cast(float, raw.x & 0xffff0000u);
        v[2] = __builtin_bit_cast(float, raw.y << 16); v[3] = __builtin_bit_cast(float, raw.y & 0xffff0000u);
        v[4] = __builtin_bit_cast(float, raw.z << 16); v[5] = __builtin_bit_cast(float, raw.z & 0xffff0000u);
        v[6] = __builtin_bit_cast(float, raw.w << 16); v[7] = __builtin_bit_cast(float, raw.w & 0xffff0000u);
        float ss = 0.f;
#pragma unroll
        for (int j = 0; j < 8; ++j) ss += v[j] * v[j];
        ss += __shfl_xor(ss, 1); ss += __shfl_xor(ss, 2); ss += __shfl_xor(ss, 4); ss += __shfl_xor(ss, 8);
        const float rstd = 1.0f / sqrtf(ss * (1.0f / 128.0f) + 1e-6f);
        const float* gn = (iswa ? wa_gain : na_gain) + (isq ? 0 : 128) + 8 * sub;
        const f32x4 g0 = *(const f32x4*)gn, g1 = *(const f32x4*)(gn + 4);
        v[0] *= rstd * g0.x; v[1] *= rstd * g0.y; v[2] *= rstd * g0.z; v[3] *= rstd * g0.w; v[4] *= rstd * g1.x; v[5] *= rstd * g1.y; v[6] *= rstd * g1.z; v[7] *= rstd * g1.w;
        if (iswa) {
            float pv[8];
#pragma unroll
            for (int j = 0; j < 8; ++j) pv[j] = __shfl_xor(v[j], 4);
            if (row < ML) {
                const int t = row & (SEQ - 1), pos = (sub >= 8) ? (t & 63) : (t >> 6);
                const int i0 = (8 * sub) & 31; const bool first = ((8 * sub) & 63) < 32;
                const float* tp = rope + ((size_t)pos * 32 + i0) * 2;
#pragma unroll
                for (int j = 0; j < 8; ++j) { const float c = tp[2 * j], s = tp[2 * j + 1]; v[j] = first ? (v[j] * c - pv[j] * s) : (v[j] * c + pv[j] * s); }
            }
        }
        if (isq) {
#pragma unroll
            for (int j = 0; j < 8; ++j) v[j] *= QSCALE;
        }
        u32x4 o; o.x = cvt_pk_bf16(v[0], v[1]); o.y = cvt_pk_bf16(v[2], v[3]); o.z = cvt_pk_bf16(v[4], v[5]); o.w = cvt_pk_bf16(v[6], v[7]);
        *(u32x4*)p = o;
    }
}

constexpr int POOL_A_OFF = 0, POOL_AS = 272, POOL_B_OFF = 256 * POOL_AS, POOL_LDS_END = POOL_B_OFF + 128 * POOL_AS;
static_assert(POOL_LDS_END <= LDSCTL_OFF, "pool LDS map");
template <int WIN> __device__ __forceinline__ void pool_a_tile(const bf16_t* __restrict__ up  , int t0, int L, int tid, LAS char* lds) {
#pragma unroll 2
    for (int it = 0; it < 8; ++it) { const int item = it * 512 + tid, row = item >> 4, cg = item & 15, t = t0 + row;
        float s[8], ctr[8];
#pragma unroll
        for (int j = 0; j < 8; ++j) s[j] = 0.f;
#pragma unroll
        for (int w = 0; w < WIN; ++w) { const int tt = t - WIN / 2 + w; const bool ok = (tt >= 0) && (tt < L); const int tc = tt < 0 ? 0 : (tt > L - 1 ? L - 1 : tt);
            const u32x4 raw = *(const u32x4*)(up + (size_t)tc * INW + 8 * cg); const float m = ok ? 1.f : 0.f;
            float f[8]; f[0] = __builtin_bit_cast(float, raw.x << 16); f[1] = __builtin_bit_cast(float, raw.x & 0xffff0000u); f[2] = __builtin_bit_cast(float, raw.y << 16); f[3] = __builtin_bit_cast(float, raw.y & 0xffff0000u);
            f[4] = __builtin_bit_cast(float, raw.z << 16); f[5] = __builtin_bit_cast(float, raw.z & 0xffff0000u); f[6] = __builtin_bit_cast(float, raw.w << 16); f[7] = __builtin_bit_cast(float, raw.w & 0xffff0000u);
#pragma unroll
            for (int j = 0; j < 8; ++j) { s[j] = fmaf(f[j], m, s[j]); if (w == WIN / 2) ctr[j] = f[j]; } }
        int lo = t - WIN / 2; lo = lo < 0 ? 0 : lo; int hi_ = t + WIN / 2 - 1; hi_ = hi_ > L - 1 ? L - 1 : hi_;
        const float inv = 1.0f / (float)(hi_ - lo + 1);
        u32x4 o; o.x = cvt_pk_bf16(s[0] * inv - ctr[0], s[1] * inv - ctr[1]); o.y = cvt_pk_bf16(s[2] * inv - ctr[2], s[3] * inv - ctr[3]);
        o.z = cvt_pk_bf16(s[4] * inv - ctr[4], s[5] * inv - ctr[5]); o.w = cvt_pk_bf16(s[6] * inv - ctr[6], s[7] * inv - ctr[7]);
        *(LAS u32x4*)(lds + POOL_A_OFF + row * POOL_AS + cg * 16) = o; }
}
__device__ __forceinline__ void pool_unit(const bf16_t* __restrict__ P, bf16_t* __restrict__ MIX, const float* __restrict__ pw, const float* __restrict__ pscale, int pm, int g, LAS char* lds) {
    int tid = threadIdx.x; asm volatile("" : "+v"(tid));
    const int wid = tid >> 6, lane = tid & 63, r32 = lane & 31, hi = lane >> 5;
    const int rowbase = pm * 256;
    int seq0, L; if (pm < ML / 256) { seq0 = (pm >> 5) * SEQ; L = SEQ; } else { seq0 = ML + (pm - ML / 256) * NCTX; L = NCTX; }
    __syncthreads();
    { const bf16_t* up = P + (size_t)seq0 * INW + PC_U + g * 128; const int t0 = rowbase - seq0;
      if (g == 0) pool_a_tile<2>(up, t0, L, tid, lds); else if (g == 1) pool_a_tile<4>(up, t0, L, tid, lds); else if (g == 2) pool_a_tile<8>(up, t0, L, tid, lds); else pool_a_tile<16>(up, t0, L, tid, lds);
      for (int idx = tid; idx < 128 * 128; idx += 512) { const int cc = idx >> 7, e = idx & 127;
          *(LAS unsigned short*)(lds + POOL_B_OFF + e * POOL_AS + cc * 2) = (unsigned short)f2bf(pw[(size_t)g * 16384 + idx]); } }
    __syncthreads();
    f32x16 acc[4] = {};
#pragma unroll
    for (int ks = 0; ks < 8; ++ks) { const bf16x8 a = *(const LAS bf16x8*)(lds + POOL_A_OFF + (32 * wid + r32) * POOL_AS + (16 * ks + 8 * hi) * 2);
#pragma unroll
        for (int nbk = 0; nbk < 4; ++nbk) { const bf16x8 bb = *(const LAS bf16x8*)(lds + POOL_B_OFF + (32 * nbk + r32) * POOL_AS + (16 * ks + 8 * hi) * 2);
            acc[nbk] = __builtin_amdgcn_mfma_f32_32x32x16_bf16(a, bb, acc[nbk], 0, 0, 0); } }
#pragma unroll
    for (int nbk = 0; nbk < 4; ++nbk) { const int e = 32 * nbk + r32; const float sc = pscale[g * 128 + e];
#pragma unroll
        for (int r = 0; r < 16; ++r) { const int row = rowbase + 32 * wid + att::crow(r, hi);
            MIX[(size_t)row * DM + 512 + g * 128 + e] = (bf16_t)f2bf(acc[nbk][r] * sc); } }
}

constexpr int NPH = 1 + 11 * DEPTH;
struct Args { const float* in[19]; float* out; unsigned char* ws; int ph_lo, ph_hi; };

template <int PHMASK> __global__ void __launch_bounds__(512, 2) fwd_kernel(Args args) {
    extern __shared__ __attribute__((aligned(16))) unsigned char lds_raw[];
    LAS unsigned char* lds = (LAS unsigned char*)lds_raw;
    const int G = gridDim.x, ngw = G * 8;
#define PHASE_IDS() int tid = threadIdx.x; asm volatile("" : "+v"(tid)); const int lane = tid & 63, wave = __builtin_amdgcn_readfirstlane(tid >> 6); \
    int bx = blockIdx.x; asm volatile("" : "+s"(bx)); const int vcu = (G % 8 == 0) ? (bx % 8) * (G / 8) + bx / 8 : bx; const int gw = vcu * 8 + wave; (void)lane; (void)gw; (void)vcu
    unsigned char* ws = args.ws;
    unsigned* ctl = (unsigned*)(ws + WS_CTL);
    float* MOD = (float*)(ws + WS_MOD);
    float* ROPE = (float*)(ws + WS_ROPE);
    float* XC = (float*)(ws + WS_XC);
    float* DUML = (float*)(ws + WS_END); float* DUMC = (float*)(ws + WS_END + 256 * MiB);
    bf16_t* H = (bf16_t*)(ws + WS_H); bf16_t* HID = (bf16_t*)(ws + WS_HID); bf16_t* P = (bf16_t*)(ws + WS_P); bf16_t* MIX = (bf16_t*)(ws + WS_MIX);
    const float* x_in = args.in[0]; const float* c_in = args.in[1]; const float* ctx_in = args.in[2]; const float* cctx_in = args.in[3];
    const float* w_mod = args.in[4]; const float* b_mod = args.in[5]; const float* norm_w = args.in[6];
    const float* na_gain = args.in[13]; const float* na_rpb = args.in[14]; const float* pool_w = args.in[15]; const float* pool_scale = args.in[16];
    const float* wa_gain = args.in[17]; const float* wa_sink = args.in[18];
    float* xout = args.out;

    { const int t0 = threadIdx.x; if (t0 < 128) ((LAS unsigned*)(lds + LDSCTL_OFF))[t0] = 0u; }
    __syncthreads();
    const int lo = args.ph_lo, hi = args.ph_hi;
#if MK_SINGLE
    XcdBarrier bar = xcd_barrier_post(ctl + CW_BAR, (volatile LAS unsigned*)(lds + LDSCTL_OFF + 32));
#define GRID_BAR() xcd_barrier(bar)
#else
#define GRID_BAR() do { } while (0)
#endif
#define IN(k) (lo <= (k) && (k) < hi)
#define PHON(k) ((PHMASK >> (k)) & 1)
#define DUPREP(k) _Pragma("unroll") for (int rep = 0; rep <= ((DUPMASK >> (k)) & 1); ++rep)
#define ISDUMMY(k) (rep < ((DUPMASK >> (k)) & 1))
#define SEAM(k) do { if (IN((k) + 1)) GRID_BAR(); } while (0)

    if (PHON(0) && IN(0)) {
        PHASE_IDS();
        LAS float* scr = (LAS float*)(lds + wave * 16384);
        constexpr int I_WI = (DM / 64) * (2 * DFF / 64), I_WO = (DFF / 64) * (DM / 64), I_IN = (DM / 64) * (INW / 64), I_OUT = (DM / 64) * (DM / 64);
        constexpr int I_LAYER = 2 * I_WI + 2 * I_WO + I_IN + I_OUT;
        DUPREP(0)
        for (int it = gw; it < DEPTH * I_LAYER; it += ngw) {
            const int l = it / I_LAYER; int r = it - l * I_LAYER;
            unsigned char* wl = ws + WS_W + (size_t)l * W_LAYER;
            if (r < I_WI) { transpose_item(args.in[7] + (size_t)l * DM * 2 * DFF, DM, 2 * DFF, (bf16_t*)(wl + W_WI1), true, r, lane); continue; } r -= I_WI;
            if (r < I_WI) { transpose_item(args.in[9] + (size_t)l * DM * 2 * DFF, DM, 2 * DFF, (bf16_t*)(wl + W_WI2), true, r, lane); continue; } r -= I_WI;
            if (r < I_WO) { transpose_item(args.in[8] + (size_t)l * DFF * DM, DFF, DM, (bf16_t*)(wl + W_WO1), false, r, lane); continue; } r -= I_WO;
            if (r < I_WO) { transpose_item(args.in[10] + (size_t)l * DFF * DM, DFF, DM, (bf16_t*)(wl + W_WO2), false, r, lane); continue; } r -= I_WO;
            if (r < I_IN) { transpose_item(args.in[11] + (size_t)l * DM * INW, DM, INW, (bf16_t*)(wl + W_WIN), false, r, lane); continue; } r -= I_IN;
            transpose_item(args.in[12] + (size_t)l * DM * DM, DM, DM, (bf16_t*)(wl + W_WOUT), false, r, lane);
        }
        for (int it = gw; it < DEPTH * 72 * 16; it += ngw) {
            const int l = it / (72 * 16), r = it - l * (72 * 16), cc = r >> 4, ks = r & 15;
            LAS float* sv = scr;
            for (int i = lane; i < 5 * 128; i += 64) { const int s = i >> 7, k = ks * 128 + (i & 127); sv[i] = silu_f(s < 4 ? c_in[s * DM + k] : cctx_in[k]); }
            LDS_WAIT(); asm volatile("" ::: "memory");
            const float* wp = w_mod + ((size_t)l * DM + ks * 128) * MODW + cc * 256 + 4 * lane;
            f32x4 a0 = {0, 0, 0, 0}, a1 = a0, a2 = a0, a3 = a0, a4 = a0;
#pragma unroll 8
            for (int k = 0; k < 128; ++k) { const f32x4 w = *(const f32x4*)(wp + (size_t)k * MODW);
                a0 += w * sv[k]; a1 += w * sv[128 + k]; a2 += w * sv[256 + k]; a3 += w * sv[384 + k]; a4 += w * sv[512 + k]; }
            if (ks == 0) { const f32x4 bb = *(const f32x4*)(b_mod + (size_t)l * MODW + cc * 256 + 4 * lane); a0 += bb; a1 += bb; a2 += bb; a3 += bb; a4 += bb; }
            float* mo = MOD + (size_t)l * 5 * MODW + cc * 256 + 4 * lane;
#pragma unroll
            for (int j = 0; j < 4; ++j) { unsafeAtomicAdd(mo + j, a0[j]); unsafeAtomicAdd(mo + MODW + j, a1[j]); unsafeAtomicAdd(mo + 2 * MODW + j, a2[j]); unsafeAtomicAdd(mo + 3 * MODW + j, a3[j]); unsafeAtomicAdd(mo + 4 * MODW + j, a4[j]); }
            LDS_WAIT(); asm volatile("" ::: "memory");
        }
        for (int i = gw * 64 + lane; i < MC * DM / 4; i += ngw * 64) ((f32x4*)XC)[i] = ((const f32x4*)ctx_in)[i];
        { const int gt = gw * 64 + lane; if (gt < 128 * 32) { const int pos = gt >> 5, i = gt & 31; const float f = exp2f(-(float)i * 0.4152410118609203f); float c, s; sincos_small((float)pos * f, c, s); ROPE[2 * gt] = c; ROPE[2 * gt + 1] = s; } }
        SEAM(0);
    }

#pragma unroll LAYER_UNROLL
    for (int l = 0; l < DEPTH; ++l) {
        const int pb = 1 + 11 * l;
        unsigned char* wl = ws + WS_W + (size_t)l * W_LAYER;
        const float* modl = MOD + (size_t)l * 5 * MODW;
        const float* nw = norm_w + (size_t)l * 3 * DM;
        const float* xl_cur = (l == 0) ? x_in : xout;
        const float* xc_cur = XC;
        const bool lastl = (l == DEPTH - 1); const int MPOST = lastl ? ML : MT;

        if (PHON(1) && IN(pb + 0)) { DUPREP(1) { PHASE_IDS(); norm_phase(xl_cur, xc_cur, nw, modl, 0, 1, H, MT, gw, ngw, lane); } SEAM(pb + 0); }
        if (PHON(2) && IN(pb + 1)) {
            DUPREP(2) {
            PHASE_IDS();
            pg8::Gemm g{H, (const bf16_t*)(wl + W_WI1), MT, 2 * DFF, DM, DM}; pg8::StaticOrder S; S.init(MT, 2 * DFF, G, bx);
            pg8::EpiSwiglu E{HID};
            pg8::gemm_phase<pg8::EpiSwiglu, pg8::StaticOrder, true, true>(lds, g, S, E);
            }
            SEAM(pb + 1);
        }
        if (PHON(3) && IN(pb + 2)) {
            DUPREP(3) {
            PHASE_IDS();
            pg8::Gemm g{HID, (const bf16_t*)(wl + W_WO1), ML, DM, DFF, DFF}; pg8::StaticOrder S; S.init(ML, DM, G, bx);
            pg8::EpiResid E{xl_cur, XC, ISDUMMY(3) ? DUML : xout, XC, modl + 2 * DM, 0.5f};
            pg8::gemm_phase<pg8::EpiResid, pg8::StaticOrder, true, true>(lds, g, S, E);
            if (!ISDUMMY(3)) {
                pg8::Gemm gc{HID + (size_t)ML * DFF, (const bf16_t*)(wl + W_WO1), MC, DM, DFF / 4, DFF}; pg8::CtxSplitOrder SC{bx, (unsigned)(DFF / 4) * 2u};
                pg8::EpiResidAtomic EC{XC, modl + 4 * MODW + 2 * DM, 0.5f};
                pg8::gemm_phase<pg8::EpiResidAtomic, pg8::CtxSplitOrder, true, true>(lds, gc, SC, EC);
            }
            }
            SEAM(pb + 2);
        }
        if (PHON(4) && IN(pb + 3)) { DUPREP(4) { PHASE_IDS(); norm_phase(xout, XC, nw + DM, modl, 3, 4, H, MT, gw, ngw, lane); } SEAM(pb + 3); }
        if (PHON(5) && IN(pb + 4)) {
            DUPREP(5) {
            PHASE_IDS();
            pg8::Gemm g{H, (const bf16_t*)(wl + W_WIN), MT, INW, DM, DM}; pg8::StaticOrder S; S.init(MT, INW, G, bx);
            pg8::EpiBf16 E{P, INW};
            pg8::gemm_phase<pg8::EpiBf16, pg8::StaticOrder, true, true>(lds, g, S, E);
            }
            SEAM(pb + 4);
        }
        if (PHON(6) && IN(pb + 5)) { PHASE_IDS(); prep_phase(P, na_gain + (size_t)l * 256, wa_gain + (size_t)l * 256, ROPE, gw * 64 + lane, ngw * 64); SEAM(pb + 5); }
        if (PHON(7) && IN(pb + 6)) {
            DUPREP(7) {
            PHASE_IDS();
            const float* sinkp = wa_sink + l * 8; const float* rpbp = na_rpb + (size_t)l * 4 * 15 * 31;
            constexpr int U_WA = 1024, U_NA = 512;
            const int U_CN = lastl ? 0 : 16, U_CW = lastl ? 0 : 32, U_ATT = U_WA + U_NA + U_CN + U_CW, U_POOL = (MPOST / 256) * 4;
            for (int idx = vcu; idx < U_ATT + U_POOL; idx += G) {
                if (idx < U_WA) { att::attn_unit(P, MIX, sinkp, rpbp, 0, idx >> 8, (idx >> 2) & 63, idx & 3, (LAS char*)lds); }
                else if (idx < U_WA + U_NA) { const int r = idx - U_WA; att::attn_unit(P, MIX, sinkp, rpbp, 1, r >> 7, (r >> 2) & 31, r & 3, (LAS char*)lds); }
                else if (idx < U_WA + U_NA + U_CN) { const int r = idx - U_WA - U_NA; att::attn_unit(P, MIX, sinkp, rpbp, 2, r >> 2, r & 3, 0, (LAS char*)lds); }
                else if (idx < U_ATT) { const int r = idx - U_WA - U_NA - U_CN; att::attn_unit(P, MIX, sinkp, rpbp, 3, r >> 3, r & 7, 0, (LAS char*)lds); }
                else { const int r = idx - U_ATT; __syncthreads(); pool_unit(P, MIX, pool_w + (size_t)l * 4 * 16384, pool_scale + (size_t)l * 512, r >> 2, r & 3, (LAS char*)lds); }
            }
            }
            SEAM(pb + 6);
        }
        if (PHON(8) && IN(pb + 7)) {
            DUPREP(8) {
            PHASE_IDS();
            pg8::Gemm g{MIX, (const bf16_t*)(wl + W_WOUT), ML, DM, DM, DM}; pg8::StaticOrder S; S.init(ML, DM, G, bx);
            pg8::EpiResid E{xout, XC, ISDUMMY(8) ? DUML : xout, XC, modl + 5 * DM, 1.0f};
            pg8::gemm_phase<pg8::EpiResid, pg8::StaticOrder, true, true>(lds, g, S, E);
            if (!lastl && !ISDUMMY(8)) {
                pg8::Gemm gc{MIX + (size_t)ML * DM, (const bf16_t*)(wl + W_WOUT), MC, DM, DM / 4, DM}; pg8::CtxSplitOrder SC{bx, (unsigned)(DM / 4) * 2u};
                pg8::EpiResidAtomic EC{XC, modl + 4 * MODW + 5 * DM, 1.0f};
                pg8::gemm_phase<pg8::EpiResidAtomic, pg8::CtxSplitOrder, true, true>(lds, gc, SC, EC);
            }
            }
            SEAM(pb + 7);
        }
        if (PHON(9) && IN(pb + 8)) { DUPREP(9) { PHASE_IDS(); norm_phase(xout, XC, nw + 2 * DM, modl, 6, 7, H, MPOST, gw, ngw, lane); } SEAM(pb + 8); }
        if (PHON(10) && IN(pb + 9)) {
            DUPREP(10) {
            PHASE_IDS();
            pg8::Gemm g{H, (const bf16_t*)(wl + W_WI2), MPOST, 2 * DFF, DM, DM}; pg8::StaticOrder S; S.init(MPOST, 2 * DFF, G, bx);
            pg8::EpiSwiglu E{HID};
            pg8::gemm_phase<pg8::EpiSwiglu, pg8::StaticOrder, true, true>(lds, g, S, E);
            }
            SEAM(pb + 9);
        }
        if (PHON(11) && IN(pb + 10)) {
            DUPREP(11) {
            PHASE_IDS();
            pg8::Gemm g{HID, (const bf16_t*)(wl + W_WO2), ML, DM, DFF, DFF}; pg8::StaticOrder S; S.init(ML, DM, G, bx);
            pg8::EpiResid E{xout, XC, ISDUMMY(11) ? DUML : xout, XC, modl + 8 * DM, 0.5f};
            pg8::gemm_phase<pg8::EpiResid, pg8::StaticOrder, true, true>(lds, g, S, E);
            if (!lastl && !ISDUMMY(11)) {
                pg8::Gemm gc{HID + (size_t)ML * DFF, (const bf16_t*)(wl + W_WO2), MC, DM, DFF / 4, DFF}; pg8::CtxSplitOrder SC{bx, (unsigned)(DFF / 4) * 2u};
                pg8::EpiResidAtomic EC{XC, modl + 4 * MODW + 8 * DM, 0.5f};
                pg8::gemm_phase<pg8::EpiResidAtomic, pg8::CtxSplitOrder, true, true>(lds, gc, SC, EC);
            }
            }
            if (l + 1 < DEPTH) SEAM(pb + 10);
        }
    }
#undef IN
#undef SEAM
#undef GRID_BAR
}

template <int PHMASK> static bool prep_kernel(int& per_cu) {
    if (hipFuncSetAttribute((const void*)fwd_kernel<PHMASK>, hipFuncAttributeMaxDynamicSharedMemorySize, LDS_BYTES) != hipSuccess) { fprintf(stderr, "kernel_launch: hipFuncSetAttribute failed (mask %x)\n", PHMASK); return false; }
    if (hipOccupancyMaxActiveBlocksPerMultiprocessor(&per_cu, (const void*)fwd_kernel<PHMASK>, 512, LDS_BYTES) != hipSuccess || per_cu < 1) fprintf(stderr, "kernel_launch: occupancy query reports %d (mask %x)\n", per_cu, PHMASK);
    (void)hipGetLastError();
    return true;
}
template <int PHMASK> static void launch_k(int grid, const Args& a, hipStream_t stream) { hipLaunchKernelGGL(fwd_kernel<PHMASK>, dim3(grid), dim3(512), LDS_BYTES, stream, a); }
extern "C" void kernel_launch(void* const* d_in, const int* in_sizes, int n_in, void* d_out, int out_size, void* d_ws, size_t ws_size, hipStream_t stream) {
    static int grid = 0;
    if (grid == 0) {
        if (n_in != 19 || in_sizes[0] != ML * DM || out_size != ML * DM || ws_size < WS_END + (DUPMASK ? 264 * MiB : 0)) {
            fprintf(stderr, "kernel_launch: shape mismatch: n_in %d in0 %d out %d ws %zu (need %zu)\n", n_in, n_in > 0 ? in_sizes[0] : -1, out_size, ws_size, (size_t)WS_END); grid = -1; return; }
        int dev = 0, cus = 0, per_cu = 0; bool ok = true;
        if (hipGetDevice(&dev) != hipSuccess || hipDeviceGetAttribute(&cus, hipDeviceAttributeMultiprocessorCount, dev) != hipSuccess) { grid = -1; return; }
#if MK_SINGLE
        ok = prep_kernel<0xFFF>(per_cu);
#else
        ok = prep_kernel<1>(per_cu) && prep_kernel<2>(per_cu) && prep_kernel<4>(per_cu) && prep_kernel<8>(per_cu) && prep_kernel<16>(per_cu) && prep_kernel<32>(per_cu) && prep_kernel<64>(per_cu)
          && prep_kernel<128>(per_cu) && prep_kernel<256>(per_cu) && prep_kernel<512>(per_cu) && prep_kernel<1024>(per_cu) && prep_kernel<2048>(per_cu);
#endif
        if (!ok) { grid = -1; return; }
        grid = cus;
    }
    if (grid < 0) return;
    if (hipMemsetAsync((char*)d_ws + WS_CTL, 0, CTL_ZERO_BYTES, stream) != hipSuccess) { fprintf(stderr, "kernel_launch: memset failed\n"); return; }
    Args a{};
    for (int i = 0; i < 19; ++i) a.in[i] = (const float*)d_in[i];
    a.out = (float*)d_out; a.ws = (unsigned char*)d_ws;
#if MK_SINGLE
    a.ph_lo = 0; a.ph_hi = NPH;
    launch_k<0xFFF>(grid, a, stream);
#else
    for (int ph = 0; ph < NPH; ++ph) { a.ph_lo = ph; a.ph_hi = ph + 1;
        const int bit = (ph == 0) ? 0 : 1 + (ph - 1) % 11;
        switch (bit) { case 0: launch_k<1>(grid, a, stream); break; case 1: launch_k<2>(grid, a, stream); break; case 2: launch_k<4>(grid, a, stream); break; case 3: launch_k<8>(grid, a, stream); break;
            case 4: launch_k<16>(grid, a, stream); break; case 5: launch_k<32>(grid, a, stream); break; case 6: launch_k<64>(grid, a, stream); break; case 7: launch_k<128>(grid, a, stream); break;
            case 8: launch_k<256>(grid, a, stream); break; case 9: launch_k<512>(grid, a, stream); break; case 10: launch_k<1024>(grid, a, stream); break; default: launch_k<2048>(grid, a, stream); break; } }
#endif
    const hipError_t le = hipPeekAtLastError();
    if (le != hipSuccess) fprintf(stderr, "kernel_launch: launch failed: %s\n", hipGetErrorName(le));
}
```

```cpp
#include <hip/hip_runtime.h>
#include <cstdio>
#include <cstdint>

#ifndef DBG_MASK
#define DBG_MASK 0xFFF
#endif
#ifndef DUPMASK
#define DUPMASK 0
#endif
#ifndef ATT_PIPE2
#define ATT_PIPE2 1
#endif
#ifndef LAYER_UNROLL
#define LAYER_UNROLL 2
#endif
#ifndef MK_SINGLE
#define MK_SINGLE 1
#endif

#define GAS __attribute__((address_space(1)))
#define LAS __attribute__((address_space(3)))
typedef unsigned short bf16_t;
typedef short bf16x8 __attribute__((ext_vector_type(8)));
typedef short s16x4 __attribute__((ext_vector_type(4)));
typedef float f32x4 __attribute__((ext_vector_type(4)));
typedef float f32x16 __attribute__((ext_vector_type(16)));
typedef unsigned u32x4 __attribute__((ext_vector_type(4)));
typedef unsigned u32x2 __attribute__((ext_vector_type(2)));

constexpr int DM = 2048, NBATCH = 4, SEQ = 8192, NCTX = 256, DFF = 5632, INW = 3584, DEPTH = 2, MODW = 9 * DM;
constexpr int ML = NBATCH * SEQ, MC = NBATCH * NCTX, MT = ML + MC;
constexpr float LOG2E = 1.4426950408889634f;
constexpr float QSCALE = 0.088388347648318440f * LOG2E;
constexpr int PC_NQ = 0, PC_NK = 512, PC_NV = 1024, PC_U = 1536, PC_WQ = 2048, PC_WK = 3072, PC_WV = 3328;

constexpr size_t MiB = 1u << 20;
constexpr size_t WS_CTL = 0, CTL_ZERO_BYTES = 1 * MiB;
constexpr size_t WS_MOD = 256 * 1024;
constexpr size_t WS_ROPE = 1 * MiB;
constexpr size_t WS_W = 2 * MiB;
constexpr size_t W_WI1 = 0, W_WO1 = 44 * MiB, W_WIN = 66 * MiB, W_WOUT = 80 * MiB, W_WI2 = 88 * MiB, W_WO2 = 132 * MiB, W_LAYER = 154 * MiB;
constexpr size_t WS_XC = WS_W + 2 * W_LAYER;
constexpr size_t WS_H = WS_XC + 8 * MiB;
constexpr size_t WS_HID = WS_H + 132 * MiB;
constexpr size_t WS_P = WS_HID;
constexpr size_t WS_MIX = WS_HID + 231 * MiB;
constexpr size_t WS_PART = WS_HID + 363 * MiB;
constexpr size_t WS_END = WS_PART + 32 * MiB;
static_assert((size_t)MT * DFF * 2 == 363 * MiB && (size_t)MT * INW * 2 == 231 * MiB && (size_t)MT * DM * 2 == 132 * MiB, "ws map");
static_assert(WS_MOD + (size_t)DEPTH * 5 * MODW * 4 <= CTL_ZERO_BYTES, "MOD inside the zeroed region");
constexpr int CW_BAR = 4096;

constexpr int LDS_BYTES = 147456;
constexpr int LDSCTL_OFF = LDS_BYTES - 512;

__device__ __forceinline__ unsigned f2bf(float f) { unsigned u = __builtin_bit_cast(unsigned, f); return (u + 0x7fffu + ((u >> 16) & 1u)) >> 16; }
__device__ __forceinline__ unsigned cvt_pk_bf16(float lo, float hi) { unsigned r; asm volatile("v_cvt_pk_bf16_f32 %0, %1, %2" : "=v"(r) : "v"(lo), "v"(hi)); return r; }
__device__ __forceinline__ float bf2f(unsigned short b) { return __builtin_bit_cast(float, (unsigned)b << 16); }
__device__ __forceinline__ float wave_sum(float v) {
#pragma unroll
    for (int o = 1; o < 64; o <<= 1) v += __shfl_xor(v, o);
    return v;
}
#define LDS_WAIT() asm volatile("s_waitcnt lgkmcnt(0)" ::: "memory")
#define VM_WAIT() asm volatile("s_waitcnt vmcnt(0)" ::: "memory")

namespace pg8 {
constexpr int BM = 256, BK = 64, HALF = 128, HTB = HALF * BK * 2, STAGE_BYTES = 8 * HTB, NXCD = 8, WGM = 8;
__host__ __device__ __forceinline__ int lds_byte(int r, int c) { const int st = (r >> 4) * 2 + (c >> 5), rr = r & 15, cc = c & 31, ob = rr * 64 + cc * 2; return st * 1024 + (ob ^ (((ob >> 9) & 1) << 5)); }
__host__ __device__ __forceinline__ void stage_rc(int b, int& R, int& C) { const int st = b / 1024, sb = b % 1024, swz = sb ^ (((sb >> 9) & 1) << 5); R = (st >> 1) * 16 + swz / 64; C = (st & 1) * 32 + (swz % 64) / 2; }
__host__ __device__ __forceinline__ int perm32(int rho) { const int n = rho >> 4, i = rho & 15; return 8 * (i >> 2) + 4 * n + (i & 3); }
struct Unit { int pm, pn; unsigned koff; };
struct Gemm { const bf16_t* A; const bf16_t* Bt; int M, N, K, ld; };
struct StaticOrder {
    int nM, nN, nwg, G, c;
    __host__ __device__ void init(int M, int N, int G_, int c_) { nM = M / BM; nN = N / BM; nwg = nM * nN; G = G_; c = c_; }
    __host__ __device__ bool next(int i, Unit& u) const {
        const long L = (long)i * G + c; if (L >= nwg) return false;
        int wgid = (int)L; { const int q = nwg / NXCD, r = nwg % NXCD, xcd = wgid % NXCD, off = wgid / NXCD; wgid = (xcd < r ? xcd * (q + 1) : r * (q + 1) + (xcd - r) * q) + off; }
        const int nig = WGM * nN, gid = wgid / nig, fm = gid * WGM, gsz = (nM - fm) < WGM ? (nM - fm) : WGM;
        u.pm = fm + ((wgid % nig) % gsz); u.pn = (wgid % nig) / gsz; u.koff = 0u; return true;
    }
    __device__ __forceinline__ void a_ready(const Unit&) const {}
    __device__ __forceinline__ void done(const Unit&) const {}
};

struct EpiBf16 {
    static constexpr bool PERM = true, AFTER_DRAIN = false;
    bf16_t* O; int ldc;
    __device__ __forceinline__ void operator()(const f32x4 (&acc)[2][2][4][2], const Unit& u, int wr, int wc, int fr, int fq) const {
        const int row0 = u.pm * BM + wr * 64 + fr, col0 = u.pn * BM + wc * 32 + 8 * fq;
#pragma unroll
        for (int ai = 0; ai < 2; ++ai)
#pragma unroll
            for (int m = 0; m < 4; ++m) { bf16_t* rowp = O + (size_t)(row0 + ai * HALF + m * 16) * ldc + col0;
#pragma unroll
                for (int bj = 0; bj < 2; ++bj) { const f32x4 v0 = acc[ai][bj][m][0], v1 = acc[ai][bj][m][1];
                    u32x4 w; w.x = cvt_pk_bf16(v0[0], v0[1]); w.y = cvt_pk_bf16(v0[2], v0[3]); w.z = cvt_pk_bf16(v1[0], v1[1]); w.w = cvt_pk_bf16(v1[2], v1[3]);
                    *(u32x4*)(rowp + bj * HALF) = w; } }
    }
};
__device__ __forceinline__ float silu_mul(float a, float b) { return a * b * __builtin_amdgcn_rcpf(1.0f + __builtin_amdgcn_exp2f(-a * LOG2E)); }
struct EpiSwiglu {
    static constexpr bool PERM = true, AFTER_DRAIN = false;
    bf16_t* O;
    __device__ __forceinline__ void operator()(const f32x4 (&acc)[2][2][4][2], const Unit& u, int wr, int wc, int fr, int fq) const {
        const int row0 = u.pm * BM + wr * 64 + fr, col0 = u.pn * HALF + wc * 32 + 8 * fq;
#pragma unroll
        for (int ai = 0; ai < 2; ++ai)
#pragma unroll
            for (int m = 0; m < 4; ++m) { bf16_t* rowp = O + (size_t)(row0 + ai * HALF + m * 16) * DFF + col0;
                const f32x4 a0 = acc[ai][0][m][0], a1 = acc[ai][0][m][1], b0 = acc[ai][1][m][0], b1 = acc[ai][1][m][1];
                u32x4 w; w.x = cvt_pk_bf16(silu_mul(a0[0], b0[0]), silu_mul(a0[1], b0[1])); w.y = cvt_pk_bf16(silu_mul(a0[2], b0[2]), silu_mul(a0[3], b0[3]));
                w.z = cvt_pk_bf16(silu_mul(a1[0], b1[0]), silu_mul(a1[1], b1[1])); w.w = cvt_pk_bf16(silu_mul(a1[2], b1[2]), silu_mul(a1[3], b1[3]));
                *(u32x4*)rowp = w; }
    }
};
struct EpiResid {
    static constexpr bool PERM = false, AFTER_DRAIN = false;
    const float* xin_l; const float* xin_c; float* xout_l; float* xout_c; const float* gate; float gs;
    __device__ __forceinline__ void operator()(const f32x4 (&acc)[2][2][4][2], const Unit& u, int wr, int wc, int fr, int fq) const {
        const bool lat = u.pm < (ML / BM); const int s = lat ? (u.pm >> 5) : 4;
        const float* xi = lat ? xin_l + (size_t)u.pm * BM * DM : xin_c + (size_t)(u.pm - ML / BM) * BM * DM;
        float* xo = lat ? xout_l + (size_t)u.pm * BM * DM : xout_c + (size_t)(u.pm - ML / BM) * BM * DM;
        const int r0 = wr * 64 + fr, col0 = u.pn * BM + wc * 32 + 4 * fq;
        const float* gp = gate + (size_t)s * MODW + col0;
#pragma unroll
        for (int bj = 0; bj < 2; ++bj)
#pragma unroll
            for (int n = 0; n < 2; ++n) { const f32x4 gv = *(const f32x4*)(gp + bj * HALF + n * 16) * gs;
#pragma unroll
                for (int ai = 0; ai < 2; ++ai)
#pragma unroll
                    for (int m = 0; m < 4; ++m) { const size_t off = (size_t)(r0 + ai * HALF + m * 16) * DM + col0 + bj * HALF + n * 16;
                        const f32x4 xv = *(const f32x4*)(xi + off); *(f32x4*)(xo + off) = xv + gv * acc[ai][bj][m][n]; } }
    }
};

struct CtxSplitOrder {
    int c; unsigned kq_bytes;
    __device__ bool next(int i, Unit& u) const { if (i != 0 || c >= 128) return false; const int t = c >> 2; u.pm = t & 3; u.pn = t >> 2; u.koff = (unsigned)(c & 3) * kq_bytes; return true; }
    __device__ __forceinline__ void a_ready(const Unit&) const {}
    __device__ __forceinline__ void done(const Unit&) const {}
};
struct EpiPartial {
    static constexpr bool PERM = false, AFTER_DRAIN = false;
    float* part; const float* gate; float gs; unsigned kqb;
    __device__ __forceinline__ void operator()(const f32x4 (&acc)[2][2][4][2], const Unit& u, int wr, int wc, int fr, int fq) const {
        float* xo = part + (size_t)(u.koff / kqb) * MC * DM + (size_t)u.pm * BM * DM;
        const int r0 = wr * 64 + fr, col0 = u.pn * BM + wc * 32 + 4 * fq;
        const float* gp = gate + col0;
#pragma unroll
        for (int bj = 0; bj < 2; ++bj)
#pragma unroll
            for (int n = 0; n < 2; ++n) { const f32x4 gv = *(const f32x4*)(gp + bj * HALF + n * 16) * gs;
#pragma unroll
                for (int ai = 0; ai < 2; ++ai)
#pragma unroll
                    for (int m = 0; m < 4; ++m) *(f32x4*)(xo + (size_t)(r0 + ai * HALF + m * 16) * DM + col0 + bj * HALF + n * 16) = gv * acc[ai][bj][m][n]; }
    }
};

template <class Epi, class Sched, bool ALIGN_EPI = false, bool SP2 = false>
__device__ __forceinline__ void gemm_phase(LAS unsigned char* lds, const Gemm g, const Sched& S, const Epi& E) {
    int tid = threadIdx.x; asm volatile("" : "+v"(tid));
    const int wid = __builtin_amdgcn_readfirstlane(tid >> 6), lane = tid & 63, wr = wid >> 2, wc = wid & 3, fr = lane & 15, fq = lane >> 4;
    const int K = g.ld, nt = g.K / BK;
    unsigned voffA[2], voffB[2];
#pragma unroll
    for (int i = 0; i < 2; ++i) { int R, C; stage_rc(tid * 16 + i * 8192, R, C); const int Rb = Epi::PERM ? ((R & ~31) + perm32(R & 31)) : R;
        voffA[i] = (unsigned)(R * K + C) * 2u; voffB[i] = (unsigned)(Rb * K + C) * 2u; }
    const size_t kstep = (size_t)(BK * 2);
    const size_t hstep = (size_t)HALF * K * 2;
    const size_t tstep = 2 * hstep;
    const unsigned ldsw = (unsigned)wid * 1024u;
    const int aoff = lds_byte(wr * 64 + fr, fq * 8), boff = lds_byte(wc * 32 + fr, fq * 8);
#define PG8_SA(b, h) (((b) * 2 + (h)) * HTB)
#define PG8_SB(b, h) ((4 + (b) * 2 + (h)) * HTB)
#define PG8_STAGE(bufoff, gbase, voff) do { _Pragma("unroll") for (int _i = 0; _i < 2; ++_i) \
        __builtin_amdgcn_global_load_lds((const unsigned*)((const char*)(gbase) + (voff)[_i]), (LAS unsigned*)(lds + (bufoff) + ldsw + _i * 8192), 16, 0, 0); } while (0)
#define PG8_LDA(dst, b, h) do { _Pragma("unroll") for (int m = 0; m < 4; ++m) _Pragma("unroll") for (int k = 0; k < 2; ++k) dst[m][k] = *(const LAS bf16x8*)(lds + PG8_SA(b, h) + aoff + m * 2048 + k * 1024); } while (0)
#define PG8_LDB(dst, b, h) do { _Pragma("unroll") for (int n = 0; n < 2; ++n) _Pragma("unroll") for (int k = 0; k < 2; ++k) dst[n][k] = *(const LAS bf16x8*)(lds + PG8_SB(b, h) + boff + n * 2048 + k * 1024); } while (0)
#define PG8_MMA(ai, bj, At, Bt) do { __builtin_amdgcn_s_setprio(1); _Pragma("unroll") for (int m = 0; m < 4; ++m) _Pragma("unroll") for (int n = 0; n < 2; ++n) _Pragma("unroll") for (int k = 0; k < 2; ++k) \
        acc[ai][bj][m][n] = __builtin_amdgcn_mfma_f32_16x16x32_bf16(Bt[n][k], At[m][k], acc[ai][bj][m][n], 0, 0, 0); __builtin_amdgcn_s_setprio(0); } while (0)
#define PG8_WAIT_V(n) asm volatile("s_waitcnt vmcnt(" #n ")" ::: "memory")
#define PG8_WAIT_L(n) asm volatile("s_waitcnt lgkmcnt(" #n ")" ::: "memory")
#define PG8_BAR __builtin_amdgcn_s_barrier()
#define PG8_SCHED __builtin_amdgcn_sched_barrier(0)
    Unit cur, nxt; int ui = 0;
    if (!S.next(0, cur)) return;
    f32x4 acc[2][2][4][2];
#pragma unroll
    for (int a = 0; a < 2; ++a)
#pragma unroll
        for (int b = 0; b < 2; ++b)
#pragma unroll
            for (int m = 0; m < 4; ++m)
#pragma unroll
                for (int n = 0; n < 2; ++n) acc[a][b][m][n] = (f32x4){0.f, 0.f, 0.f, 0.f};
    bf16x8 At[4][2], B0[2][2], B1[2][2];
    const char* cA = (const char*)g.A + (size_t)cur.pm * tstep + cur.koff; const char* cB = (const char*)g.Bt + (size_t)cur.pn * tstep + cur.koff;
    S.a_ready(cur);
    if constexpr (SP2) {
        PG8_STAGE(PG8_SB(0, 0), cB, voffB); PG8_STAGE(PG8_SB(0, 1), cB + hstep, voffB); PG8_STAGE(PG8_SA(0, 0), cA, voffA); PG8_STAGE(PG8_SA(0, 1), cA + hstep, voffA);
        if (wr == 1) PG8_BAR;
        PG8_WAIT_V(2); PG8_BAR;
        PG8_STAGE(PG8_SB(1, 0), cB + kstep, voffB); PG8_STAGE(PG8_SA(1, 0), cA + kstep, voffA); PG8_STAGE(PG8_SB(1, 1), cB + hstep + kstep, voffB);
        PG8_WAIT_V(6); PG8_BAR;
    } else {
        PG8_STAGE(PG8_SB(0, 0), cB, voffB); PG8_STAGE(PG8_SA(0, 0), cA, voffA); PG8_STAGE(PG8_SB(0, 1), cB + hstep, voffB); PG8_STAGE(PG8_SA(0, 1), cA + hstep, voffA);
        if (wr == 1) PG8_BAR;
        PG8_WAIT_V(4); PG8_BAR;
        PG8_STAGE(PG8_SB(1, 0), cB + kstep, voffB); PG8_STAGE(PG8_SA(1, 0), cA + kstep, voffA); PG8_STAGE(PG8_SB(1, 1), cB + hstep + kstep, voffB);
        PG8_WAIT_V(6); PG8_BAR;
    }
    for (;;) {
        const bool has_next = S.next(ui + 1, nxt);
        const char* nA = has_next ? (const char*)g.A + (size_t)nxt.pm * tstep + nxt.koff : cA; const char* nB = has_next ? (const char*)g.Bt + (size_t)nxt.pn * tstep + nxt.koff : cB;
        for (int t = 0; t < nt; t += 2) {
            const bool last = (t == nt - 2);
            const char* a1 = cA + (size_t)(t + 1) * kstep;
            const char* a2 = last ? nA : cA + (size_t)(t + 2) * kstep; const char* b2 = last ? nB : cB + (size_t)(t + 2) * kstep;
            const char* a3 = a2 + kstep; const char* b3 = b2 + kstep;
            if (last && has_next) S.a_ready(nxt);
            if constexpr (SP2) {
            PG8_LDB(B0, 0, 0); PG8_LDB(B1, 0, 1); PG8_SCHED; PG8_LDA(At, 0, 0); PG8_STAGE(PG8_SA(1, 1), a1 + hstep, voffA);
            PG8_WAIT_V(8); PG8_WAIT_L(0); PG8_BAR; PG8_MMA(0, 0, At, B0); PG8_MMA(0, 1, At, B1); PG8_BAR; PG8_SCHED;
            PG8_LDA(At, 0, 1); PG8_STAGE(PG8_SB(0, 0), b2, voffB); PG8_STAGE(PG8_SB(0, 1), b2 + hstep, voffB); PG8_STAGE(PG8_SA(0, 0), a2, voffA);
            PG8_WAIT_V(8); PG8_WAIT_L(0); PG8_BAR; PG8_MMA(1, 0, At, B0); PG8_MMA(1, 1, At, B1); PG8_BAR; PG8_SCHED;
            PG8_LDB(B0, 1, 0); PG8_LDB(B1, 1, 1); PG8_SCHED; PG8_LDA(At, 1, 0); PG8_STAGE(PG8_SA(0, 1), a2 + hstep, voffA);
            PG8_WAIT_V(8); PG8_WAIT_L(0); PG8_BAR; PG8_MMA(0, 0, At, B0); PG8_MMA(0, 1, At, B1); PG8_BAR; PG8_SCHED;
            PG8_LDA(At, 1, 1); PG8_STAGE(PG8_SB(1, 0), b3, voffB); PG8_STAGE(PG8_SB(1, 1), b3 + hstep, voffB); PG8_STAGE(PG8_SA(1, 0), a3, voffA);
            PG8_WAIT_V(8); PG8_WAIT_L(0); PG8_BAR; PG8_MMA(1, 0, At, B0); PG8_MMA(1, 1, At, B1); PG8_BAR; PG8_SCHED;
            } else {
            PG8_LDB(B0, 0, 0); PG8_SCHED; PG8_LDA(At, 0, 0); PG8_STAGE(PG8_SA(1, 1), a1 + hstep, voffA);
            PG8_WAIT_L(8); PG8_BAR; PG8_WAIT_L(0); PG8_MMA(0, 0, At, B0); PG8_BAR; PG8_SCHED;
            PG8_LDB(B1, 0, 1); PG8_STAGE(PG8_SB(0, 0), b2, voffB);
            PG8_BAR; PG8_WAIT_L(0); PG8_MMA(0, 1, At, B1); PG8_BAR;
            PG8_LDA(At, 0, 1); PG8_STAGE(PG8_SA(0, 0), a2, voffA);
            PG8_BAR; PG8_WAIT_L(0); PG8_MMA(1, 0, At, B0); PG8_BAR; PG8_SCHED;
            PG8_STAGE(PG8_SB(0, 1), b2 + hstep, voffB);
            PG8_WAIT_V(6); PG8_BAR; PG8_MMA(1, 1, At, B1); PG8_BAR;
            PG8_LDB(B0, 1, 0); PG8_SCHED; PG8_LDA(At, 1, 0); PG8_STAGE(PG8_SA(0, 1), a2 + hstep, voffA);
            PG8_WAIT_L(8); PG8_BAR; PG8_WAIT_L(0); PG8_MMA(0, 0, At, B0); PG8_BAR; PG8_SCHED;
            PG8_LDB(B1, 1, 1); PG8_STAGE(PG8_SB(1, 0), b3, voffB);
            PG8_BAR; PG8_WAIT_L(0); PG8_MMA(0, 1, At, B1); PG8_BAR;
            PG8_LDA(At, 1, 1); PG8_STAGE(PG8_SA(1, 0), a3, voffA);
            PG8_BAR; PG8_WAIT_L(0); PG8_MMA(1, 0, At, B0); PG8_BAR; PG8_SCHED;
            PG8_STAGE(PG8_SB(1, 1), b3 + hstep, voffB);
            PG8_WAIT_V(6); PG8_BAR; PG8_MMA(1, 1, At, B1); PG8_BAR;
            }
        }
        if constexpr (ALIGN_EPI) { if (wr == 0) PG8_BAR; }
        if constexpr (!Epi::AFTER_DRAIN) { E(acc, cur, wr, wc, fr, fq); S.done(cur); }
        if (!has_next) break;
#pragma unroll
        for (int a = 0; a < 2; ++a)
#pragma unroll
            for (int b = 0; b < 2; ++b)
#pragma unroll
                for (int m = 0; m < 4; ++m)
#pragma unroll
                    for (int n = 0; n < 2; ++n) acc[a][b][m][n] = (f32x4){0.f, 0.f, 0.f, 0.f};
        cur = nxt; cA = nA; cB = nB; ++ui;
        if constexpr (ALIGN_EPI) { if (wr == 1) PG8_BAR; }
    }
    PG8_WAIT_V(0);
    if constexpr (!ALIGN_EPI) { if (wr == 0) PG8_BAR; }
    PG8_BAR;
#undef PG8_SA
#undef PG8_SB
#undef PG8_STAGE
#undef PG8_LDA
#undef PG8_LDB
#undef PG8_MMA
#undef PG8_WAIT_V
#undef PG8_WAIT_L
#undef PG8_BAR
#undef PG8_SCHED
}
}

namespace att {
constexpr int SHM_V = 64 * 128 * 2, SHM_K = SHM_V;
constexpr int OFF_V = 0, OFF_K = 2 * SHM_V, OFF_WS = 4 * SHM_V, OFF_OST = OFF_WS + 2048, OST_WAVE = 32 * 272, OFF_RPB = OFF_OST + 8 * OST_WAVE, ATT_LDS_END = OFF_RPB + 2048;
static_assert(ATT_LDS_END <= LDSCTL_OFF, "attention LDS map");
constexpr float THR = 11.5f;
#define KSWZ(row, colB) ((row) * 256 + ((colB) ^ (((row) & 7) << 4)))
#define SBAR() __builtin_amdgcn_sched_barrier(0)
__device__ __forceinline__ int crow(int r, int hi) { return (r & 3) + 8 * (r >> 2) + 4 * hi; }
__device__ __forceinline__ void partialSM(f32x16& p0, f32x16& p1, float& m_reg, float& mn, float& alpha) {
    float pmax = p0[0];
#pragma unroll
    for (int r = 1; r < 16; ++r) pmax = fmaxf(pmax, p0[r]);
#pragma unroll
    for (int r = 0; r < 16; ++r) pmax = fmaxf(pmax, p1[r]);
    { auto rr = __builtin_amdgcn_permlane32_swap(__float_as_uint(pmax), __float_as_uint(pmax), false, false);
      pmax = fmaxf(__uint_as_float(rr[0]), __uint_as_float(rr[1])); }
    if (__builtin_expect(__all(pmax - m_reg <= THR), 1)) { mn = m_reg; alpha = 1.f; }
    else { mn = fmaxf(m_reg, pmax); alpha = __builtin_amdgcn_exp2f(m_reg - mn); m_reg = mn; }
#pragma unroll
    for (int r = 0; r < 16; ++r) p0[r] = p0[r] - mn;
#pragma unroll
    for (int r = 0; r < 16; ++r) p1[r] = p1[r] - mn;
#pragma unroll
    for (int r = 0; r < 16; ++r) p0[r] = __builtin_amdgcn_exp2f(p0[r]);
}
__device__ __forceinline__ void finishSM(f32x16& p0, f32x16& p1, float alpha, float& l_reg, bf16x8& pa0, bf16x8& pa1, bf16x8& pa2, bf16x8& pa3) {
#pragma unroll
    for (int r = 0; r < 16; ++r) p1[r] = __builtin_amdgcn_exp2f(p1[r]);
    float ps = 0;
#pragma unroll
    for (int r = 0; r < 16; ++r) ps += p0[r];
#pragma unroll
    for (int r = 0; r < 16; ++r) ps += p1[r];
    { auto rr = __builtin_amdgcn_permlane32_swap(__float_as_uint(ps), __float_as_uint(ps), false, false);
      ps = __uint_as_float(rr[0]) + __uint_as_float(rr[1]); }
    l_reg = l_reg * alpha + ps;
#define PK4(P, BASE, OUT) do { unsigned a0 = cvt_pk_bf16(P[BASE + 0], P[BASE + 1]), a1 = cvt_pk_bf16(P[BASE + 2], P[BASE + 3]);   \
    unsigned b0 = cvt_pk_bf16(P[BASE + 4], P[BASE + 5]), b1 = cvt_pk_bf16(P[BASE + 6], P[BASE + 7]);                              \
    auto r0 = __builtin_amdgcn_permlane32_swap(a0, b0, false, false); auto r1 = __builtin_amdgcn_permlane32_swap(a1, b1, false, false); \
    u32x4 w = {r0[0], r1[0], r0[1], r1[1]}; OUT = __builtin_bit_cast(bf16x8, w); } while (0)
    PK4(p0, 0, pa0); PK4(p0, 8, pa1); PK4(p1, 0, pa2); PK4(p1, 8, pa3);
#undef PK4
}
__device__ __forceinline__ void qkt(f32x16& p0, f32x16& p1, const LAS char* Ks, const bf16x8* qr, int r32, int hi) {
    p0 = f32x16{}; p1 = f32x16{};
#pragma unroll
    for (int d0 = 0; d0 < 8; ++d0) { const int cb = (d0 * 16 + hi * 8) * 2;
        const bf16x8 b0 = *(const LAS bf16x8*)(Ks + KSWZ(r32, cb));
        const bf16x8 b1 = *(const LAS bf16x8*)(Ks + KSWZ(32 + r32, cb));
        p0 = __builtin_amdgcn_mfma_f32_32x32x16_bf16(b0, qr[d0], p0, 0, 0, 0);
        p1 = __builtin_amdgcn_mfma_f32_32x32x16_bf16(b1, qr[d0], p1, 0, 0, 0); }
}
__device__ __forceinline__ int v_st(int k, int c) { const int kk = (k & ~0xC) | ((k & 4) << 1) | ((k & 8) >> 1); return ((kk >> 3) * 4 + (c >> 5)) * 512 + ((kk & 7) * 32 + (c & 31)) * 2; }
__device__ __forceinline__ int v_rd_base(int lane) { return ((lane & 3) << 3) | (((lane >> 2) & 3) << 6) | (((lane >> 4) & 1) << 5) | (((lane >> 5) & 1) << 8); }
constexpr int v_rd_off(int d0, int ks, int half) { return d0 * 512 + ks * 4096 + half * 2048; }
template <int OFF> __device__ __forceinline__ s16x4 tr_read(int vb) {
    s16x4 r; asm volatile("ds_read_b64_tr_b16 %0, %1 offset:%2" : "=&v"(r) : "v"(vb), "i"(OFF) : "memory"); return r;
}
template <int D0> __device__ __forceinline__ void pv_one(f32x16& od, int vb, bf16x8 pa0, bf16x8 pa1, bf16x8 pa2, bf16x8 pa3) {
    const s16x4 l0 = tr_read<v_rd_off(D0, 0, 0)>(vb), h0 = tr_read<v_rd_off(D0, 0, 1)>(vb), l1 = tr_read<v_rd_off(D0, 1, 0)>(vb), h1 = tr_read<v_rd_off(D0, 1, 1)>(vb);
    const s16x4 l2 = tr_read<v_rd_off(D0, 2, 0)>(vb), h2 = tr_read<v_rd_off(D0, 2, 1)>(vb), l3 = tr_read<v_rd_off(D0, 3, 0)>(vb), h3 = tr_read<v_rd_off(D0, 3, 1)>(vb);
    asm volatile("s_waitcnt lgkmcnt(0)" ::: "memory"); SBAR();
#define PK(L, H) (bf16x8){L[0], L[1], L[2], L[3], H[0], H[1], H[2], H[3]}
    od = __builtin_amdgcn_mfma_f32_32x32x16_bf16(pa0, PK(l0, h0), od, 0, 0, 0);
    od = __builtin_amdgcn_mfma_f32_32x32x16_bf16(pa1, PK(l1, h1), od, 0, 0, 0);
    od = __builtin_amdgcn_mfma_f32_32x32x16_bf16(pa2, PK(l2, h2), od, 0, 0, 0);
    od = __builtin_amdgcn_mfma_f32_32x32x16_bf16(pa3, PK(l3, h3), od, 0, 0, 0);
#undef PK
}
__device__ __forceinline__ void pv_d0(f32x16* o, int vb, bf16x8 pa0, bf16x8 pa1, bf16x8 pa2, bf16x8 pa3) {
    pv_one<0>(o[0], vb, pa0, pa1, pa2, pa3); pv_one<1>(o[1], vb, pa0, pa1, pa2, pa3); pv_one<2>(o[2], vb, pa0, pa1, pa2, pa3); pv_one<3>(o[3], vb, pa0, pa1, pa2, pa3);
}

struct Mask { int kind, nb, jlo, pq  , rk0, qr, qc  ; const LAS float* rpb; };
__device__ __forceinline__ void apply_mask(f32x16& p0, f32x16& p1, const Mask& M, int t, int hi) {
    if (t >= M.nb) return;
    const float NEG = -__builtin_inff();
#define CR(r) (((r) & 3) + 8 * ((r) >> 2))
    if (M.kind == 0) {
        const int jt = M.jlo + t;
        if (jt < 2) { const int lim = M.pq - 64 * jt - 4 * hi;
#pragma unroll
            for (int r = 0; r < 16; ++r) { p0[r] = (CR(r) >= lim) ? p0[r] : NEG; p1[r] = (CR(r) + 32 >= lim) ? p1[r] : NEG; }
        } else if (jt >= 4) { const int lim = M.pq - 64 * (jt - 4) - 4 * hi;
#pragma unroll
            for (int r = 0; r < 16; ++r) { p0[r] = (CR(r) <= lim) ? p0[r] : NEG; p1[r] = (CR(r) + 32 <= lim) ? p1[r] : NEG; }
        }
    } else if (M.kind == 1) {
        const int kr = M.rk0 + t; int r0q = M.qr - 4; r0q = r0q < 0 ? 0 : (r0q > 120 ? 120 : r0q);
        const bool rowok = (kr >= r0q) && (kr < r0q + 8);
        int dr = kr - M.qr + 7; dr = dr < 0 ? 0 : (dr > 14 ? 14 : dr);
        int c0 = M.qc - 8; c0 = c0 < 0 ? 0 : (c0 > 48 ? 48 : c0);
        const int c0h = rowok ? (c0 - 4 * hi) : 1000;
        const LAS float* tb = M.rpb + dr * 31 + (15 - M.qc) + 4 * hi;
#pragma unroll
        for (int r = 0; r < 16; ++r) { const float b0 = tb[CR(r)]; p0[r] = ((unsigned)(CR(r) - c0h) < 16u) ? p0[r] + b0 : NEG; }
        SBAR();
#pragma unroll
        for (int r = 0; r < 16; ++r) { const float b1 = tb[CR(r) + 32]; p1[r] = ((unsigned)(CR(r) + 32 - c0h) < 16u) ? p1[r] + b1 : NEG; }
    }
#undef CR
}

__device__ __forceinline__ void attn_unit(const bf16_t* __restrict__ P, bf16_t* __restrict__ MIX, const float* __restrict__ sinkp, const float* __restrict__ rpbp,
                                          int kind, int b, int i1, int i2, LAS char* lds) {
    int tid = threadIdx.x; asm volatile("" : "+v"(tid));
    const int wid = __builtin_amdgcn_readfirstlane(tid >> 6), lane = tid & 63, r32 = lane & 31, hi = lane >> 5;
    LAS char* V_lds = lds + OFF_V; LAS char* K_lds = lds + OFF_K;
    LAS float* wsf = (LAS float*)(lds + OFF_WS) + wid * 64; LAS float* li_l = wsf; LAS float* al_l = wsf + 32;
    LAS float* rpb_l = (LAS float*)(lds + OFF_RPB);
    int qbase, qcol, ocol, nb, row0, kcol, vcol; float sink2 = -__builtin_inff();
    Mask MK; MK.kind = kind; MK.jlo = 0; MK.pq = 0; MK.rk0 = 0; MK.qr = 0; MK.qc = 0; MK.rpb = rpb_l;
    if (kind == 0) {
        const int n = i1, kvh = i2 >> 1, gp = i2 & 1, g = 2 * gp + (wid >> 2), qh = 4 * kvh + g, p0q = 32 * (wid & 3);
        qbase = b * SEQ + n * 128 + p0q; qcol = PC_WQ + qh * 128; ocol = 1024 + qh * 128;
        const int jlo = (n == 0) ? 2 : 0, jhi = (n == SEQ / 128 - 1) ? 4 : 6; nb = jhi - jlo; row0 = b * SEQ + (n - 1) * 128 + 64 * jlo;
        kcol = PC_WK + kvh * 128; vcol = PC_WV + kvh * 128; sink2 = sinkp[qh] * LOG2E;
        MK.jlo = jlo; MK.pq = p0q + r32;
    } else if (kind == 1) {
        const int r = 4 * i1, h = i2, qr = r + (wid >> 1), c32 = 32 * (wid & 1);
        qbase = b * SEQ + qr * 64 + c32; qcol = PC_NQ + h * 128; ocol = h * 128;
        int rk0 = r - 4; rk0 = rk0 < 0 ? 0 : (rk0 > 116 ? 116 : rk0); nb = 12; row0 = b * SEQ + rk0 * 64;
        kcol = PC_NK + h * 128; vcol = PC_NV + h * 128;
        MK.rk0 = rk0; MK.qr = qr; MK.qc = c32 + r32;
        if (tid < 15 * 31) rpb_l[tid] = rpbp[h * (15 * 31) + tid] * LOG2E;
    } else if (kind == 2) {
        const int h = i1; qbase = ML + b * NCTX + 32 * wid; qcol = PC_NQ + h * 128; ocol = h * 128; nb = 0; row0 = 0; kcol = PC_NK + h * 128; vcol = PC_NV + h * 128;
    } else {
        const int qh = i1, kvh = qh >> 2; qbase = ML + b * NCTX + 32 * wid; qcol = PC_WQ + qh * 128; ocol = 1024 + qh * 128; nb = 0; row0 = 0;
        kcol = PC_WK + kvh * 128; vcol = PC_WV + kvh * 128; sink2 = sinkp[qh] * LOG2E;
    }
    MK.nb = nb;
    const int crow0 = ML + b * NCTX, NT = nb + 4;
    float m_reg = -1e30f, l_reg = 0; f32x16 o[4] = {}; bf16x8 qr[8];
    { const bf16_t* Qw = P + (size_t)(qbase + r32) * INW + qcol + hi * 8;
#pragma unroll
      for (int d0 = 0; d0 < 8; ++d0) qr[d0] = *(const bf16x8*)(Qw + d0 * 16); }
    const int sr = tid >> 4, sc = (tid & 15) * 8, vst0 = v_st(sr, sc), vst1 = v_st(32 + sr, sc);
    const int vb0 = (int)(unsigned)(size_t)V_lds + v_rd_base(lane);
#define TROW(t) (((t) < nb) ? (row0 + 64 * (t)) : (crow0 + 64 * ((t) - nb)))
#define RESC(a) do { if (__any((a) < 1.f)) { if (hi == 0) al_l[r32] = (a); asm volatile("s_waitcnt lgkmcnt(0)" ::: "memory"); \
    _Pragma("unroll") for (int d = 0; d < 4; ++d) _Pragma("unroll") for (int r = 0; r < 16; ++r) o[d][r] *= al_l[crow(r, hi)]; } } while (0)
#if ATT_PIPE2
    struct { bf16x8 vs0, vs1, ks0, ks1; } sr_[2];
#define SLOAD(i, t) do { const bf16_t* _b = P + (size_t)(TROW(t) + sr) * INW + sc; \
    sr_[i].vs0 = *(const bf16x8*)(_b + vcol); sr_[i].vs1 = *(const bf16x8*)(_b + (size_t)32 * INW + vcol); \
    sr_[i].ks0 = *(const bf16x8*)(_b + kcol); sr_[i].ks1 = *(const bf16x8*)(_b + (size_t)32 * INW + kcol); } while (0)
#define SWRITE(bb, i) do { *(LAS bf16x8*)(V_lds + (bb) * SHM_V + vst0) = sr_[i].vs0; *(LAS bf16x8*)(V_lds + (bb) * SHM_V + vst1) = sr_[i].vs1; const int kc_ = sc * 2; \
    *(LAS bf16x8*)(K_lds + (bb) * SHM_K + KSWZ(sr, kc_)) = sr_[i].ks0; *(LAS bf16x8*)(K_lds + (bb) * SHM_K + KSWZ(32 + sr, kc_)) = sr_[i].ks1; } while (0)
#define SWAIT() asm volatile("s_waitcnt vmcnt(4)" ::: "memory")
    f32x16 pA0, pA1, pB0, pB1; float mnA, mnB, alA, alB; bf16x8 pa0, pa1, pa2, pa3;
    constexpr int SE = 0, SO = 1;
    SLOAD(SE, 0); asm volatile("s_waitcnt vmcnt(0)" ::: "memory"); SWRITE(0, SE); __syncthreads();
    qkt(pA0, pA1, K_lds, qr, r32, hi); apply_mask(pA0, pA1, MK, 0, hi); partialSM(pA0, pA1, m_reg, mnA, alA);
    SLOAD(SO, 1); if (2 < NT) SLOAD(SE, 2);
    SWAIT(); SWRITE(1, SO); __syncthreads();
    for (int j = 1; j + 1 < NT; j += 2) {
        SBAR(); qkt(pB0, pB1, K_lds + SHM_K, qr, r32, hi);
        finishSM(pA0, pA1, alA, l_reg, pa0, pa1, pa2, pa3); SBAR();
        SLOAD(SO, j + 2); SBAR();
        pv_d0(o, vb0, pa0, pa1, pa2, pa3); apply_mask(pB0, pB1, MK, j, hi); partialSM(pB0, pB1, m_reg, mnB, alB);
        __syncthreads(); SWAIT(); SWRITE(0, SE);
        RESC(alB); __syncthreads();
        SBAR(); qkt(pA0, pA1, K_lds, qr, r32, hi);
        finishSM(pB0, pB1, alB, l_reg, pa0, pa1, pa2, pa3); SBAR();
        if (j + 3 < NT) SLOAD(SE, j + 3); SBAR();
        pv_d0(o, vb0 + SHM_V, pa0, pa1, pa2, pa3); apply_mask(pA0, pA1, MK, j + 1, hi); partialSM(pA0, pA1, m_reg, mnA, alA);
        __syncthreads(); SWAIT(); SWRITE(1, SO);
        RESC(alA); __syncthreads();
    }
    SBAR(); qkt(pB0, pB1, K_lds + SHM_K, qr, r32, hi);
    finishSM(pA0, pA1, alA, l_reg, pa0, pa1, pa2, pa3); SBAR();
    pv_d0(o, vb0, pa0, pa1, pa2, pa3); apply_mask(pB0, pB1, MK, NT - 1, hi); partialSM(pB0, pB1, m_reg, mnB, alB);
    __syncthreads(); RESC(alB);
    finishSM(pB0, pB1, alB, l_reg, pa0, pa1, pa2, pa3); SBAR();
    pv_d0(o, vb0 + SHM_V, pa0, pa1, pa2, pa3);
#undef SWAIT
#else
    bf16x8 vs0, vs1, ks0, ks1;
#define SLOAD(t) do { const bf16_t* _b = P + (size_t)(TROW(t) + sr) * INW + sc; \
    vs0 = *(const bf16x8*)(_b + vcol); vs1 = *(const bf16x8*)(_b + (size_t)32 * INW + vcol); \
    ks0 = *(const bf16x8*)(_b + kcol); ks1 = *(const bf16x8*)(_b + (size_t)32 * INW + kcol); } while (0)
#define SWRITE(bb) do { *(LAS bf16x8*)(V_lds + (bb) * SHM_V + vst0) = vs0; *(LAS bf16x8*)(V_lds + (bb) * SHM_V + vst1) = vs1; const int kc_ = sc * 2; \
    *(LAS bf16x8*)(K_lds + (bb) * SHM_K + KSWZ(sr, kc_)) = ks0; *(LAS bf16x8*)(K_lds + (bb) * SHM_K + KSWZ(32 + sr, kc_)) = ks1; } while (0)
    SLOAD(0); asm volatile("s_waitcnt vmcnt(0)" ::: "memory"); SWRITE(0); SLOAD(1); __syncthreads();
    for (int j = 0; j < NT; ++j) {
        const int bsel = j & 1;
        f32x16 p0, p1; float mn, al; bf16x8 pa0, pa1, pa2, pa3;
        qkt(p0, p1, K_lds + bsel * SHM_K, qr, r32, hi);
        apply_mask(p0, p1, MK, j, hi);
        partialSM(p0, p1, m_reg, mn, al);
        RESC(al);
        finishSM(p0, p1, al, l_reg, pa0, pa1, pa2, pa3);
        pv_d0(o, vb0 + bsel * SHM_V, pa0, pa1, pa2, pa3);
        if (j + 1 < NT) { asm volatile("s_waitcnt vmcnt(0)" ::: "memory"); SWRITE(bsel ^ 1); if (j + 2 < NT) SLOAD(j + 2); }
        __syncthreads();
    }
#endif
    l_reg += __builtin_amdgcn_exp2f(sink2 - m_reg);
    if (hi == 0) li_l[r32] = l_reg; asm volatile("s_waitcnt lgkmcnt(0)" ::: "memory");
    LAS char* ost = lds + OFF_OST + wid * OST_WAVE;
#pragma unroll
    for (int r = 0; r < 16; ++r) { const int orow = crow(r, hi); const float rl = __builtin_amdgcn_rcpf(li_l[orow]);
#pragma unroll
        for (int d0 = 0; d0 < 4; ++d0) *(LAS unsigned short*)(ost + orow * 272 + (d0 * 32 + r32) * 2) = (unsigned short)f2bf(o[d0][r] * rl); }
    asm volatile("s_waitcnt lgkmcnt(0)" ::: "memory");
#pragma unroll
    for (int i = 0; i < 8; ++i) { const int id = i * 64 + lane, rr = id >> 4, c16 = id & 15;
        const u32x4 v = *(const LAS u32x4*)(ost + rr * 272 + c16 * 16);
        *(u32x4*)(MIX + (size_t)(qbase + rr) * DM + ocol + c16 * 8) = v; }
#undef TROW
#undef SLOAD
#undef SWRITE
#undef RESC
}
}

#define XB_TMO      128
#define XB_XCNT(j)  (256  + 64 * (j))
#define XB_XSUB(j)  (1280 + 64 * (j))
#define XB_XGEN(j)  (2304 + 64 * (j))
#define XB_TOP      3328
#define XB_TOPGEN   3392
#define XCD_BAR_WORDS 3456
#define XB_SPIN_CAP (1u << 18)
__device__ __forceinline__ unsigned xb_ld(unsigned* p)              { return __hip_atomic_load(p, __ATOMIC_RELAXED, __HIP_MEMORY_SCOPE_AGENT); }
__device__ __forceinline__ unsigned xb_add(unsigned* p, unsigned v) { return __hip_atomic_fetch_add(p, v, __ATOMIC_RELAXED, __HIP_MEMORY_SCOPE_AGENT); }
__device__ __forceinline__ unsigned xb_xcc_id() { return (unsigned)__builtin_amdgcn_s_getreg((3 << 11) | 20) & 0xFu; }
#define XB_SPIN(cond, bar) do { unsigned _sp = 0; while (cond) { __builtin_amdgcn_s_sleep(1); \
    if ((++_sp & 255u) == 0u) { if (xb_ld(&(bar)[XB_TMO])) break; if (_sp > XB_SPIN_CAP) { atomicAdd(&(bar)[XB_TMO], 1u); break; } } } } while (0)
struct XcdBarrier { unsigned* bar; unsigned x; volatile LAS unsigned* st; };
__device__ __forceinline__ XcdBarrier xcd_barrier_post(unsigned* bar, volatile LAS unsigned* st) {
    XcdBarrier b; b.bar = bar; b.x = xb_xcc_id(); b.st = st;
    if (threadIdx.x == 0) (void)xb_add(&bar[XB_XCNT(b.x)], 1u);
    return b;
}
__device__ __forceinline__ void xcd_barrier_complete(unsigned* bar, unsigned x, unsigned& nloc, unsigned& nx) {
    const unsigned G = gridDim.x * gridDim.y * gridDim.z;
    unsigned sum, cnt, mine, sp = 0u;
    for (;;) {
        sum = 0u; cnt = 0u; mine = 0u;
#pragma unroll
        for (unsigned j = 0; j < 16; ++j) { const unsigned c = xb_ld(&bar[XB_XCNT(j)]); sum += c; cnt += (c > 0u) ? 1u : 0u; mine = (j == x) ? c : mine; }
        if (sum == G) break;
        __builtin_amdgcn_s_sleep(1);
        if ((++sp & 255u) == 0u) { if (xb_ld(&bar[XB_TMO])) break; if (sp > XB_SPIN_CAP) { atomicAdd(&bar[XB_TMO], 1u); break; } }
    }
    nloc = mine > 0u ? mine : 1u; nx = cnt > 0u ? cnt : 1u;
}
__device__ __forceinline__ void xcd_barrier(const XcdBarrier& b) {
    asm volatile("s_waitcnt vmcnt(0)" ::: "memory");
    __syncthreads();
    if (threadIdx.x == 0) {
        unsigned* bar = b.bar;
        __builtin_amdgcn_s_waitcnt(0);
        unsigned nloc = b.st[0], nx = b.st[1];
        if (nloc == 0u) { xcd_barrier_complete(bar, b.x, nloc, nx); b.st[0] = nloc; b.st[1] = nx; }
        const unsigned old = xb_add(&bar[XB_XSUB(b.x)], 1u);
        const unsigned gen = old / nloc;
        if (old + 1u == (gen + 1u) * nloc) {
            __builtin_amdgcn_fence(__ATOMIC_RELEASE, "agent");
            asm volatile("s_waitcnt vmcnt(0)" ::: "memory");
            const unsigned og = xb_add(&bar[XB_TOP], 1u);
            const unsigned tg = og / nx;
            if (og + 1u == (tg + 1u) * nx) xb_add(&bar[XB_TOPGEN], 1u);
            else XB_SPIN(xb_ld(&bar[XB_TOPGEN]) == tg, bar);
            __builtin_amdgcn_fence(__ATOMIC_ACQUIRE, "agent");
            xb_add(&bar[XB_XGEN(b.x)], 1u);
            asm volatile("s_waitcnt vmcnt(0)" ::: "memory");
        } else {
            XB_SPIN(xb_ld(&bar[XB_XGEN(b.x)]) == gen, bar);
            __builtin_amdgcn_fence(__ATOMIC_ACQUIRE, "agent");
            asm volatile("s_waitcnt vmcnt(0)" ::: "memory");
        }
    }
    __syncthreads();
}

__device__ __forceinline__ int wt_dest_row(int n0, int N, bool swiglu) {
    if (!swiglu) return n0;
    const int half = N / 2; const int j = (n0 < half) ? n0 : n0 - half; return 256 * (j >> 7) + (j & 127) + ((n0 < half) ? 0 : 128);
}
__device__ __forceinline__ void transpose_item(const float* __restrict__ W, int K, int N, bf16_t* __restrict__ WT, bool swiglu, int item, int lane) {
    const int nblk = N / 64, kb = item / nblk, nbi = item - kb * nblk, k0 = 64 * kb, n0 = 64 * nbi;
    const int k8 = lane & 7, n4 = lane >> 3;
    const float* src = W + (size_t)(k0 + 8 * k8) * N + n0 + 4 * n4;
    f32x4 v[2][8];
#pragma unroll
    for (int h = 0; h < 2; ++h)
#pragma unroll
        for (int i = 0; i < 8; ++i) v[h][i] = __builtin_nontemporal_load((const f32x4*)(src + (size_t)i * N + 32 * h));
#pragma unroll
    for (int h = 0; h < 2; ++h) { const int d0 = wt_dest_row(n0 + 32 * h, N, swiglu);
        bf16_t* dst = WT + (size_t)(d0 + 4 * n4) * K + k0 + 8 * k8;
#pragma unroll
        for (int j = 0; j < 4; ++j) { u32x4 o; o.x = cvt_pk_bf16(v[h][0][j], v[h][1][j]); o.y = cvt_pk_bf16(v[h][2][j], v[h][3][j]); o.z = cvt_pk_bf16(v[h][4][j], v[h][5][j]); o.w = cvt_pk_bf16(v[h][6][j], v[h][7][j]);
            *(u32x4*)(dst + (size_t)j * K) = o; } }
}
__device__ __forceinline__ float silu_f(float x) { return x / (1.0f + __expf(-x)); }
__device__ __forceinline__ void sincos_small(float a, float& c, float& s) {
    const float n = rintf(a * 0.63661977236758134f);
    float r = fmaf(-n, 1.57079637050628662109375f, a); r = fmaf(n, 4.37113900018624283e-8f, r);
    const float z = r * r;
    const float sp = r + r * z * (-1.6666654611e-1f + z * (8.3321608736e-3f + z * (-1.9515295891e-4f)));
    const float cp = 1.0f - 0.5f * z + z * z * (4.166664568298827e-2f + z * (-1.388731625493765e-3f + z * 2.443315711809948e-5f));
    const int q = ((int)n) & 3;
    c = (q == 0) ? cp : (q == 1) ? -sp : (q == 2) ? -cp : sp;
    s = (q == 0) ? sp : (q == 1) ? cp : (q == 2) ? -sp : -cp;
}

__device__ __forceinline__ void norm_phase(const float* xl, const float* xc, float* xcw, const float* part, const float* g, const float* modl, int shift_chunk, int scale_chunk, bf16_t* H, int nrows, int gw, int ngw, int lane) {
    for (int row = gw; row < nrows; row += ngw) {
        const float* xr = (row < ML) ? xl + (size_t)row * DM : xc + (size_t)(row - ML) * DM;
        const int s = (row < ML) ? (row >> 13) : 4;
        const f32x4* sh = (const f32x4*)(modl + (size_t)s * MODW + shift_chunk * DM); const f32x4* scp = (const f32x4*)(modl + (size_t)s * MODW + scale_chunk * DM);
        f32x4 v[8]; float ss = 0.f;
#pragma unroll
        for (int j = 0; j < 8; ++j) v[j] = ((const f32x4*)xr)[lane + 64 * j];
        if (part != nullptr && row >= ML) {
            const f32x4* pp = (const f32x4*)(part + (size_t)(row - ML) * DM);
#pragma unroll
            for (int j = 0; j < 8; ++j) { v[j] += (pp[lane + 64 * j] + pp[(size_t)MC * DM / 4 + lane + 64 * j]) + (pp[(size_t)2 * MC * DM / 4 + lane + 64 * j] + pp[(size_t)3 * MC * DM / 4 + lane + 64 * j]);
                ((f32x4*)(xcw + (size_t)(row - ML) * DM))[lane + 64 * j] = v[j]; }
        }
#pragma unroll
        for (int j = 0; j < 8; ++j) ss += (v[j].x * v[j].x + v[j].y * v[j].y) + (v[j].z * v[j].z + v[j].w * v[j].w);
        const float rstd = 1.0f / sqrtf(wave_sum(ss) * (1.0f / DM) + 1e-6f);
        u32x2* o8 = (u32x2*)(H + (size_t)row * DM) + lane;
#pragma unroll
        for (int j = 0; j < 8; ++j) { const f32x4 gj = ((const f32x4*)g)[lane + 64 * j], sj = scp[lane + 64 * j], hj = sh[lane + 64 * j];
            const f32x4 y = v[j] * rstd * gj * (sj + 1.0f) + hj;
            u32x2 w; w.x = cvt_pk_bf16(y.x, y.y); w.y = cvt_pk_bf16(y.z, y.w); o8[64 * j] = w; }
    }
}

__device__ __forceinline__ void prep_phase(bf16_t* P, const float* na_gain, const float* wa_gain, const float* rope, int gthread, int nthreads) {
    const int sub = gthread & 15;
    for (int item = gthread >> 4; item < MT * 18; item += (nthreads >> 4)) {
        const int row = item / 18, hx = item - row * 18;
        int col; bool isq, iswa;
        if (hx < 4) { col = PC_NQ + 128 * hx; isq = true; iswa = false; }
        else if (hx < 8) { col = PC_NK + 128 * (hx - 4); isq = false; iswa = false; }
        else if (hx < 16) { col = PC_WQ + 128 * (hx - 8); isq = true; iswa = true; }
        else { col = PC_WK + 128 * (hx - 16); isq = false; iswa = true; }
        bf16_t* p = P + (size_t)row * INW + col + 8 * sub;
        const u32x4 raw = *(const u32x4*)p;
        float v[8];
        v[0] = __builtin_bit_cast(float, raw.x << 16); v[1] = __builtin_bit_cast(float, raw.x & 0xffff0000u);
        v[2] = __builtin_bit_cast(float, raw.y << 16); v[3] = __builtin_bit_cast(float, raw.y & 0xffff0000u);
        v[4] = __builtin_bit_cast(float, raw.z << 16); v[5] = __builtin_bit_cast(float, raw.z & 0xffff0000u);
        v[6] = __builtin_bit_cast(float, raw.w << 16); v[7] = __builtin_bit_cast(float, raw.w & 0xffff0000u);
        float ss = 0.f;
#pragma unroll
        for (int j = 0; j < 8; ++j) ss += v[j] * v[j];
        ss += __shfl_xor(ss, 1); ss += __shfl_xor(ss, 2); ss += __shfl_xor(ss, 4); ss += __shfl_xor(ss, 8);
        const float rstd = 1.0f / sqrtf(ss * (1.0f / 128.0f) + 1e-6f);
        const float* gn = (iswa ? wa_gain : na_gain) + (isq ? 0 : 128) + 8 * sub;
        const f32x4 g0 = *(const f32x4*)gn, g1 = *(const f32x4*)(gn + 4);
        v[0] *= rstd * g0.x; v[1] *= rstd * g0.y; v[2] *= rstd * g0.z; v[3] *= rstd * g0.w; v[4] *= rstd * g1.x; v[5] *= rstd * g1.y; v[6] *= rstd * g1.z; v[7] *= rstd * g1.w;
        if (iswa) {
            float pv[8];
#pragma unroll
            for (int j = 0; j < 8; ++j) pv[j] = __shfl_xor(v[j], 4);
            if (row < ML) {
                const int t = row & (SEQ - 1), pos = (sub >= 8) ? (t & 63) : (t >> 6);
                const int i0 = (8 * sub) & 31; const bool first = ((8 * sub) & 63) < 32;
                const float* tp = rope + ((size_t)pos * 32 + i0) * 2;
#pragma unroll
                for (int j = 0; j < 8; ++j) { const float c = tp[2 * j], s = tp[2 * j + 1]; v[j] = first ? (v[j] * c - pv[j] * s) : (v[j] * c + pv[j] * s); }
            }
        }
        if (isq) {
#pragma unroll
            for (int j = 0; j < 8; ++j) v[j] *= QSCALE;
        }
        u32x4 o; o.x = cvt_pk_bf16(v[0], v[1]); o.y = cvt_pk_bf16(v[2], v[3]); o.z = cvt_pk_bf16(v[4], v[5]); o.w = cvt_pk_bf16(v[6], v[7]);
        *(u32x4*)p = o;
    }
}

constexpr int POOL_A_OFF = 0, POOL_AS = 272, POOL_B_OFF = 256 * POOL_AS, POOL_LDS_END = POOL_B_OFF + 128 * POOL_AS;
static_assert(POOL_LDS_END <= LDSCTL_OFF, "pool LDS map");
template <int WIN> __device__ __forceinline__ void pool_a_tile(const bf16_t* __restrict__ up  , int t0, int L, int tid, LAS char* lds) {
#pragma unroll 2
    for (int it = 0; it < 8; ++it) { const int item = it * 512 + tid, row = item >> 4, cg = item & 15, t = t0 + row;
        float s[8], ctr[8];
#pragma unroll
        for (int j = 0; j < 8; ++j) s[j] = 0.f;
#pragma unroll
        for (int w = 0; w < WIN; ++w) { const int tt = t - WIN / 2 + w; const bool ok = (tt >= 0) && (tt < L); const int tc = tt < 0 ? 0 : (tt > L - 1 ? L - 1 : tt);
            const u32x4 raw = *(const u32x4*)(up + (size_t)tc * INW + 8 * cg); const float m = ok ? 1.f : 0.f;
            float f[8]; f[0] = __builtin_bit_cast(float, raw.x << 16); f[1] = __builtin_bit_cast(float, raw.x & 0xffff0000u); f[2] = __builtin_bit_cast(float, raw.y << 16); f[3] = __builtin_bit_cast(float, raw.y & 0xffff0000u);
            f[4] = __builtin_bit_cast(float, raw.z << 16); f[5] = __builtin_bit_cast(float, raw.z & 0xffff0000u); f[6] = __builtin_bit_cast(float, raw.w << 16); f[7] = __builtin_bit_cast(float, raw.w & 0xffff0000u);
#pragma unroll
            for (int j = 0; j < 8; ++j) { s[j] = fmaf(f[j], m, s[j]); if (w == WIN / 2) ctr[j] = f[j]; } }
        int lo = t - WIN / 2; lo = lo < 0 ? 0 : lo; int hi_ = t + WIN / 2 - 1; hi_ = hi_ > L - 1 ? L - 1 : hi_;
        const float inv = 1.0f / (float)(hi_ - lo + 1);
        u32x4 o; o.x = cvt_pk_bf16(s[0] * inv - ctr[0], s[1] * inv - ctr[1]); o.y = cvt_pk_bf16(s[2] * inv - ctr[2], s[3] * inv - ctr[3]);
        o.z = cvt_pk_bf16(s[4] * inv - ctr[4], s[5] * inv - ctr[5]); o.w = cvt_pk_bf16(s[6] * inv - ctr[6], s[7] * inv - ctr[7]);
        *(LAS u32x4*)(lds + POOL_A_OFF + row * POOL_AS + cg * 16) = o; }
}
__device__ __forceinline__ void pool_unit(const bf16_t* __restrict__ P, bf16_t* __restrict__ MIX, const float* __restrict__ pw, const float* __restrict__ pscale, int pm, int g, LAS char* lds) {
    int tid = threadIdx.x; asm volatile("" : "+v"(tid));
    const int wid = tid >> 6, lane = tid & 63, r32 = lane & 31, hi = lane >> 5;
    const int rowbase = pm * 256;
    int seq0, L; if (pm < ML / 256) { seq0 = (pm >> 5) * SEQ; L = SEQ; } else { seq0 = ML + (pm - ML / 256) * NCTX; L = NCTX; }
    __syncthreads();
    { const bf16_t* up = P + (size_t)seq0 * INW + PC_U + g * 128; const int t0 = rowbase - seq0;
      if (g == 0) pool_a_tile<2>(up, t0, L, tid, lds); else if (g == 1) pool_a_tile<4>(up, t0, L, tid, lds); else if (g == 2) pool_a_tile<8>(up, t0, L, tid, lds); else pool_a_tile<16>(up, t0, L, tid, lds);
      for (int idx = tid; idx < 128 * 128; idx += 512) { const int cc = idx >> 7, e = idx & 127;
          *(LAS unsigned short*)(lds + POOL_B_OFF + e * POOL_AS + cc * 2) = (unsigned short)f2bf(pw[(size_t)g * 16384 + idx]); } }
    __syncthreads();
    f32x16 acc[4] = {};
#pragma unroll
    for (int ks = 0; ks < 8; ++ks) { const bf16x8 a = *(const LAS bf16x8*)(lds + POOL_A_OFF + (32 * wid + r32) * POOL_AS + (16 * ks + 8 * hi) * 2);
#pragma unroll
        for (int nbk = 0; nbk < 4; ++nbk) { const bf16x8 bb = *(const LAS bf16x8*)(lds + POOL_B_OFF + (32 * nbk + r32) * POOL_AS + (16 * ks + 8 * hi) * 2);
            acc[nbk] = __builtin_amdgcn_mfma_f32_32x32x16_bf16(a, bb, acc[nbk], 0, 0, 0); } }
#pragma unroll
    for (int nbk = 0; nbk < 4; ++nbk) { const int e = 32 * nbk + r32; const float sc = pscale[g * 128 + e];
#pragma unroll
        for (int r = 0; r < 16; ++r) { const int row = rowbase + 32 * wid + att::crow(r, hi);
            MIX[(size_t)row * DM + 512 + g * 128 + e] = (bf16_t)f2bf(acc[nbk][r] * sc); } }
}

constexpr int NPH = 1 + 11 * DEPTH;
struct Args { const float* in[19]; float* out; unsigned char* ws; int ph_lo, ph_hi; };

template <int PHMASK> __global__ void __launch_bounds__(512, 2) fwd_kernel(Args args) {
    extern __shared__ __attribute__((aligned(16))) unsigned char lds_raw[];
    LAS unsigned char* lds = (LAS unsigned char*)lds_raw;
    const int G = gridDim.x, ngw = G * 8;
#define PHASE_IDS() int tid = threadIdx.x; asm volatile("" : "+v"(tid)); const int lane = tid & 63, wave = __builtin_amdgcn_readfirstlane(tid >> 6); \
    int bx = blockIdx.x; asm volatile("" : "+s"(bx)); const int vcu = (G % 8 == 0) ? (bx % 8) * (G / 8) + bx / 8 : bx; const int gw = vcu * 8 + wave; (void)lane; (void)gw; (void)vcu
    unsigned char* ws = args.ws;
    unsigned* ctl = (unsigned*)(ws + WS_CTL);
    float* MOD = (float*)(ws + WS_MOD);
    float* ROPE = (float*)(ws + WS_ROPE);
    float* XC = (float*)(ws + WS_XC);
    float* PART = (float*)(ws + WS_PART);
    float* DUML = (float*)(ws + WS_END); float* DUMC = (float*)(ws + WS_END + 256 * MiB);
    bf16_t* H = (bf16_t*)(ws + WS_H); bf16_t* HID = (bf16_t*)(ws + WS_HID); bf16_t* P = (bf16_t*)(ws + WS_P); bf16_t* MIX = (bf16_t*)(ws + WS_MIX);
    const float* x_in = args.in[0]; const float* c_in = args.in[1]; const float* ctx_in = args.in[2]; const float* cctx_in = args.in[3];
    const float* w_mod = args.in[4]; const float* b_mod = args.in[5]; const float* norm_w = args.in[6];
    const float* na_gain = args.in[13]; const float* na_rpb = args.in[14]; const float* pool_w = args.in[15]; const float* pool_scale = args.in[16];
    const float* wa_gain = args.in[17]; const float* wa_sink = args.in[18];
    float* xout = args.out;

    { const int t0 = threadIdx.x; if (t0 < 128) ((LAS unsigned*)(lds + LDSCTL_OFF))[t0] = 0u; }
    __syncthreads();
    const int lo = args.ph_lo, hi = args.ph_hi;
#if MK_SINGLE
    XcdBarrier bar = xcd_barrier_post(ctl + CW_BAR, (volatile LAS unsigned*)(lds + LDSCTL_OFF + 32));
#define GRID_BAR() xcd_barrier(bar)
#else
#define GRID_BAR() do { } while (0)
#endif
#define IN(k) (lo <= (k) && (k) < hi)
#define PHON(k) ((PHMASK >> (k)) & 1)
#define DUPREP(k) _Pragma("unroll") for (int rep = 0; rep <= ((DUPMASK >> (k)) & 1); ++rep)
#define ISDUMMY(k) (rep < ((DUPMASK >> (k)) & 1))
#define SEAM(k) do { if (IN((k) + 1)) GRID_BAR(); } while (0)

    if (PHON(0) && IN(0)) {
        PHASE_IDS();
        LAS float* scr = (LAS float*)(lds + wave * 16384);
        constexpr int I_WI = (DM / 64) * (2 * DFF / 64), I_WO = (DFF / 64) * (DM / 64), I_IN = (DM / 64) * (INW / 64), I_OUT = (DM / 64) * (DM / 64);
        constexpr int I_LAYER = 2 * I_WI + 2 * I_WO + I_IN + I_OUT;
        DUPREP(0)
        for (int it = gw; it < DEPTH * I_LAYER; it += ngw) {
            const int l = it / I_LAYER; int r = it - l * I_LAYER;
            unsigned char* wl = ws + WS_W + (size_t)l * W_LAYER;
            if (r < I_WI) { transpose_item(args.in[7] + (size_t)l * DM * 2 * DFF, DM, 2 * DFF, (bf16_t*)(wl + W_WI1), true, r, lane); continue; } r -= I_WI;
            if (r < I_WI) { transpose_item(args.in[9] + (size_t)l * DM * 2 * DFF, DM, 2 * DFF, (bf16_t*)(wl + W_WI2), true, r, lane); continue; } r -= I_WI;
            if (r < I_WO) { transpose_item(args.in[8] + (size_t)l * DFF * DM, DFF, DM, (bf16_t*)(wl + W_WO1), false, r, lane); continue; } r -= I_WO;
            if (r < I_WO) { transpose_item(args.in[10] + (size_t)l * DFF * DM, DFF, DM, (bf16_t*)(wl + W_WO2), false, r, lane); continue; } r -= I_WO;
            if (r < I_IN) { transpose_item(args.in[11] + (size_t)l * DM * INW, DM, INW, (bf16_t*)(wl + W_WIN), false, r, lane); continue; } r -= I_IN;
            transpose_item(args.in[12] + (size_t)l * DM * DM, DM, DM, (bf16_t*)(wl + W_WOUT), false, r, lane);
        }
        for (int it = gw; it < DEPTH * 72 * 16; it += ngw) {
            const int l = it / (72 * 16), r = it - l * (72 * 16), cc = r >> 4, ks = r & 15;
            LAS float* sv = scr;
            for (int i = lane; i < 5 * 128; i += 64) { const int s = i >> 7, k = ks * 128 + (i & 127); sv[i] = silu_f(s < 4 ? c_in[s * DM + k] : cctx_in[k]); }
            LDS_WAIT(); asm volatile("" ::: "memory");
            const float* wp = w_mod + ((size_t)l * DM + ks * 128) * MODW + cc * 256 + 4 * lane;
            f32x4 a0 = {0, 0, 0, 0}, a1 = a0, a2 = a0, a3 = a0, a4 = a0;
#pragma unroll 8
            for (int k = 0; k < 128; ++k) { const f32x4 w = *(const f32x4*)(wp + (size_t)k * MODW);
                a0 += w * sv[k]; a1 += w * sv[128 + k]; a2 += w * sv[256 + k]; a3 += w * sv[384 + k]; a4 += w * sv[512 + k]; }
            if (ks == 0) { const f32x4 bb = *(const f32x4*)(b_mod + (size_t)l * MODW + cc * 256 + 4 * lane); a0 += bb; a1 += bb; a2 += bb; a3 += bb; a4 += bb; }
            float* mo = MOD + (size_t)l * 5 * MODW + cc * 256 + 4 * lane;
#pragma unroll
            for (int j = 0; j < 4; ++j) { unsafeAtomicAdd(mo + j, a0[j]); unsafeAtomicAdd(mo + MODW + j, a1[j]); unsafeAtomicAdd(mo + 2 * MODW + j, a2[j]); unsafeAtomicAdd(mo + 3 * MODW + j, a3[j]); unsafeAtomicAdd(mo + 4 * MODW + j, a4[j]); }
            LDS_WAIT(); asm volatile("" ::: "memory");
        }
        for (int i = gw * 64 + lane; i < MC * DM / 4; i += ngw * 64) ((f32x4*)XC)[i] = ((const f32x4*)ctx_in)[i];
        { const int gt = gw * 64 + lane; if (gt < 128 * 32) { const int pos = gt >> 5, i = gt & 31; const float f = exp2f(-(float)i * 0.4152410118609203f); float c, s; sincos_small((float)pos * f, c, s); ROPE[2 * gt] = c; ROPE[2 * gt + 1] = s; } }
        SEAM(0);
    }

#pragma unroll LAYER_UNROLL
    for (int l = 0; l < DEPTH; ++l) {
        const int pb = 1 + 11 * l;
        unsigned char* wl = ws + WS_W + (size_t)l * W_LAYER;
        const float* modl = MOD + (size_t)l * 5 * MODW;
        const float* nw = norm_w + (size_t)l * 3 * DM;
        const float* xl_cur = (l == 0) ? x_in : xout;
        const float* xc_cur = XC;
        const bool lastl = (l == DEPTH - 1); const int MPOST = lastl ? ML : MT;

        if (PHON(1) && IN(pb + 0)) { DUPREP(1) { PHASE_IDS(); norm_phase(xl_cur, xc_cur, XC, (l > 0 && rep == 0) ? PART : nullptr, nw, modl, 0, 1, H, MT, gw, ngw, lane); } SEAM(pb + 0); }
        if (PHON(2) && IN(pb + 1)) {
            DUPREP(2) {
            PHASE_IDS();
            pg8::Gemm g{H, (const bf16_t*)(wl + W_WI1), MT, 2 * DFF, DM, DM}; pg8::StaticOrder S; S.init(MT, 2 * DFF, G, bx);
            pg8::EpiSwiglu E{HID};
            pg8::gemm_phase<pg8::EpiSwiglu, pg8::StaticOrder, true, true>(lds, g, S, E);
            }
            SEAM(pb + 1);
        }
        if (PHON(3) && IN(pb + 2)) {
            DUPREP(3) {
            PHASE_IDS();
            pg8::Gemm g{HID, (const bf16_t*)(wl + W_WO1), ML, DM, DFF, DFF}; pg8::StaticOrder S; S.init(ML, DM, G, bx);
            pg8::EpiResid E{xl_cur, XC, ISDUMMY(3) ? DUML : xout, XC, modl + 2 * DM, 0.5f};
            pg8::gemm_phase<pg8::EpiResid, pg8::StaticOrder, true, true>(lds, g, S, E);
            if (!ISDUMMY(3)) {
                pg8::Gemm gc{HID + (size_t)ML * DFF, (const bf16_t*)(wl + W_WO1), MC, DM, DFF / 4, DFF}; pg8::CtxSplitOrder SC{bx, (unsigned)(DFF / 4) * 2u};
                pg8::EpiPartial EC{PART, modl + 4 * MODW + 2 * DM, 0.5f, (unsigned)(DFF / 4) * 2u};
                pg8::gemm_phase<pg8::EpiPartial, pg8::CtxSplitOrder, true, true>(lds, gc, SC, EC);
            }
            }
            SEAM(pb + 2);
        }
        if (PHON(4) && IN(pb + 3)) { DUPREP(4) { PHASE_IDS(); norm_phase(xout, XC, XC, rep == 0 ? PART : nullptr, nw + DM, modl, 3, 4, H, MT, gw, ngw, lane); } SEAM(pb + 3); }
        if (PHON(5) && IN(pb + 4)) {
            DUPREP(5) {
            PHASE_IDS();
            pg8::Gemm g{H, (const bf16_t*)(wl + W_WIN), MT, INW, DM, DM}; pg8::StaticOrder S; S.init(MT, INW, G, bx);
            pg8::EpiBf16 E{P, INW};
            pg8::gemm_phase<pg8::EpiBf16, pg8::StaticOrder, true, true>(lds, g, S, E);
            }
            SEAM(pb + 4);
        }
        if (PHON(6) && IN(pb + 5)) { PHASE_IDS(); prep_phase(P, na_gain + (size_t)l * 256, wa_gain + (size_t)l * 256, ROPE, gw * 64 + lane, ngw * 64); SEAM(pb + 5); }
        if (PHON(7) && IN(pb + 6)) {
            DUPREP(7) {
            PHASE_IDS();
            const float* sinkp = wa_sink + l * 8; const float* rpbp = na_rpb + (size_t)l * 4 * 15 * 31;
            constexpr int U_WA = 1024, U_NA = 512;
            const int U_CN = lastl ? 0 : 16, U_CW = lastl ? 0 : 32, U_ATT = U_WA + U_NA + U_CN + U_CW, U_POOL = (MPOST / 256) * 4;
            for (int idx = vcu; idx < U_ATT + U_POOL; idx += G) {
                if (idx < U_WA) { att::attn_unit(P, MIX, sinkp, rpbp, 0, idx >> 8, (idx >> 2) & 63, idx & 3, (LAS char*)lds); }
                else if (idx < U_WA + U_NA) { const int r = idx - U_WA; att::attn_unit(P, MIX, sinkp, rpbp, 1, r >> 7, (r >> 2) & 31, r & 3, (LAS char*)lds); }
                else if (idx < U_WA + U_NA + U_CN) { const int r = idx - U_WA - U_NA; att::attn_unit(P, MIX, sinkp, rpbp, 2, r >> 2, r & 3, 0, (LAS char*)lds); }
                else if (idx < U_ATT) { const int r = idx - U_WA - U_NA - U_CN; att::attn_unit(P, MIX, sinkp, rpbp, 3, r >> 3, r & 7, 0, (LAS char*)lds); }
                else { const int r = idx - U_ATT; __syncthreads(); pool_unit(P, MIX, pool_w + (size_t)l * 4 * 16384, pool_scale + (size_t)l * 512, r >> 2, r & 3, (LAS char*)lds); }
            }
            }
            SEAM(pb + 6);
        }
        if (PHON(8) && IN(pb + 7)) {
            DUPREP(8) {
            PHASE_IDS();
            pg8::Gemm g{MIX, (const bf16_t*)(wl + W_WOUT), ML, DM, DM, DM}; pg8::StaticOrder S; S.init(ML, DM, G, bx);
            pg8::EpiResid E{xout, XC, ISDUMMY(8) ? DUML : xout, XC, modl + 5 * DM, 1.0f};
            pg8::gemm_phase<pg8::EpiResid, pg8::StaticOrder, true, true>(lds, g, S, E);
            if (!lastl && !ISDUMMY(8)) {
                pg8::Gemm gc{MIX + (size_t)ML * DM, (const bf16_t*)(wl + W_WOUT), MC, DM, DM / 4, DM}; pg8::CtxSplitOrder SC{bx, (unsigned)(DM / 4) * 2u};
                pg8::EpiPartial EC{PART, modl + 4 * MODW + 5 * DM, 1.0f, (unsigned)(DM / 4) * 2u};
                pg8::gemm_phase<pg8::EpiPartial, pg8::CtxSplitOrder, true, true>(lds, gc, SC, EC);
            }
            }
            SEAM(pb + 7);
        }
        if (PHON(9) && IN(pb + 8)) { DUPREP(9) { PHASE_IDS(); norm_phase(xout, XC, XC, rep == 0 ? PART : nullptr, nw + 2 * DM, modl, 6, 7, H, MPOST, gw, ngw, lane); } SEAM(pb + 8); }
        if (PHON(10) && IN(pb + 9)) {
            DUPREP(10) {
            PHASE_IDS();
            pg8::Gemm g{H, (const bf16_t*)(wl + W_WI2), MPOST, 2 * DFF, DM, DM}; pg8::StaticOrder S; S.init(MPOST, 2 * DFF, G, bx);
            pg8::EpiSwiglu E{HID};
            pg8::gemm_phase<pg8::EpiSwiglu, pg8::StaticOrder, true, true>(lds, g, S, E);
            }
            SEAM(pb + 9);
        }
        if (PHON(11) && IN(pb + 10)) {
            DUPREP(11) {
            PHASE_IDS();
            pg8::Gemm g{HID, (const bf16_t*)(wl + W_WO2), ML, DM, DFF, DFF}; pg8::StaticOrder S; S.init(ML, DM, G, bx);
            pg8::EpiResid E{xout, XC, ISDUMMY(11) ? DUML : xout, XC, modl + 8 * DM, 0.5f};
            pg8::gemm_phase<pg8::EpiResid, pg8::StaticOrder, true, true>(lds, g, S, E);
            if (!lastl && !ISDUMMY(11)) {
                pg8::Gemm gc{HID + (size_t)ML * DFF, (const bf16_t*)(wl + W_WO2), MC, DM, DFF / 4, DFF}; pg8::CtxSplitOrder SC{bx, (unsigned)(DFF / 4) * 2u};
                pg8::EpiPartial EC{PART, modl + 4 * MODW + 8 * DM, 0.5f, (unsigned)(DFF / 4) * 2u};
                pg8::gemm_phase<pg8::EpiPartial, pg8::CtxSplitOrder, true, true>(lds, gc, SC, EC);
            }
            }
            if (l + 1 < DEPTH) SEAM(pb + 10);
        }
    }
#undef IN
#undef SEAM
#undef GRID_BAR
}

template <int PHMASK> static bool prep_kernel(int& per_cu) {
    if (hipFuncSetAttribute((const void*)fwd_kernel<PHMASK>, hipFuncAttributeMaxDynamicSharedMemorySize, LDS_BYTES) != hipSuccess) { fprintf(stderr, "kernel_launch: hipFuncSetAttribute failed (mask %x)\n", PHMASK); return false; }
    if (hipOccupancyMaxActiveBlocksPerMultiprocessor(&per_cu, (const void*)fwd_kernel<PHMASK>, 512, LDS_BYTES) != hipSuccess || per_cu < 1) fprintf(stderr, "kernel_launch: occupancy query reports %d (mask %x)\n", per_cu, PHMASK);
    (void)hipGetLastError();
    return true;
}
template <int PHMASK> static void launch_k(int grid, const Args& a, hipStream_t stream) { hipLaunchKernelGGL(fwd_kernel<PHMASK>, dim3(grid), dim3(512), LDS_BYTES, stream, a); }
extern "C" void kernel_launch(void* const* d_in, const int* in_sizes, int n_in, void* d_out, int out_size, void* d_ws, size_t ws_size, hipStream_t stream) {
    static int grid = 0;
    if (grid == 0) {
        if (n_in != 19 || in_sizes[0] != ML * DM || out_size != ML * DM || ws_size < WS_END + (DUPMASK ? 264 * MiB : 0)) {
            fprintf(stderr, "kernel_launch: shape mismatch: n_in %d in0 %d out %d ws %zu (need %zu)\n", n_in, n_in > 0 ? in_sizes[0] : -1, out_size, ws_size, (size_t)WS_END); grid = -1; return; }
        int dev = 0, cus = 0, per_cu = 0; bool ok = true;
        if (hipGetDevice(&dev) != hipSuccess || hipDeviceGetAttribute(&cus, hipDeviceAttributeMultiprocessorCount, dev) != hipSuccess) { grid = -1; return; }
#if MK_SINGLE
        ok = prep_kernel<0xFFF>(per_cu);
#else
        ok = prep_kernel<1>(per_cu) && prep_kernel<2>(per_cu) && prep_kernel<4>(per_cu) && prep_kernel<8>(per_cu) && prep_kernel<16>(per_cu) && prep_kernel<32>(per_cu) && prep_kernel<64>(per_cu)
          && prep_kernel<128>(per_cu) && prep_kernel<256>(per_cu) && prep_kernel<512>(per_cu) && prep_kernel<1024>(per_cu) && prep_kernel<2048>(per_cu);
#endif
        if (!ok) { grid = -1; return; }
        grid = cus;
    }
    if (grid < 0) return;
    if (hipMemsetAsync((char*)d_ws + WS_CTL, 0, CTL_ZERO_BYTES, stream) != hipSuccess) { fprintf(stderr, "kernel_launch: memset failed\n"); return; }
    Args a{};
    for (int i = 0; i < 19; ++i) a.in[i] = (const float*)d_in[i];
    a.out = (float*)d_out; a.ws = (unsigned char*)d_ws;
#if MK_SINGLE
    a.ph_lo = 0; a.ph_hi = NPH;
    launch_k<0xFFF>(grid, a, stream);
#else
    for (int ph = 0; ph < NPH; ++ph) { a.ph_lo = ph; a.ph_hi = ph + 1;
        const int bit = (ph == 0) ? 0 : 1 + (ph - 1) % 11;
        switch (bit) { case 0: launch_k<1>(grid, a, stream); break; case 1: launch_k<2>(grid, a, stream); break; case 2: launch_k<4>(grid, a, stream); break; case 3: launch_k<8>(grid, a, stream); break;
            case 4: launch_k<16>(grid, a, stream); break; case 5: launch_k<32>(grid, a, stream); break; case 6: launch_k<64>(grid, a, stream); break; case 7: launch_k<128>(grid, a, stream); break;
            case 8: launch_k<256>(grid, a, stream); break; case 9: launch_k<512>(grid, a, stream); break; case 10: launch_k<1024>(grid, a, stream); break; default: launch_k<2048>(grid, a, stream); break; } }
#endif
    const hipError_t le = hipPeekAtLastError();
    if (le != hipSuccess) fprintf(stderr, "kernel_launch: launch failed: %s\n", hipGetErrorName(le));
}
```

```cpp
#include <hip/hip_runtime.h>
#include <cstdio>
#include <cstdint>

#ifndef DBG_MASK
#define DBG_MASK 0xFFF
#endif
#ifndef DUPMASK
#define DUPMASK 0
#endif
#ifndef ATT_PIPE2
#define ATT_PIPE2 1
#endif
#ifndef RESID_WGM
#define RESID_WGM 4
#endif
#ifndef LAYER_UNROLL
#define LAYER_UNROLL 2
#endif
#ifndef MK_SINGLE
#define MK_SINGLE 1
#endif

#define GAS __attribute__((address_space(1)))
#define LAS __attribute__((address_space(3)))
typedef unsigned short bf16_t;
typedef short bf16x8 __attribute__((ext_vector_type(8)));
typedef short s16x4 __attribute__((ext_vector_type(4)));
typedef float f32x4 __attribute__((ext_vector_type(4)));
typedef float f32x16 __attribute__((ext_vector_type(16)));
typedef unsigned u32x4 __attribute__((ext_vector_type(4)));
typedef unsigned u32x2 __attribute__((ext_vector_type(2)));

constexpr int DM = 2048, NBATCH = 4, SEQ = 8192, NCTX = 256, DFF = 5632, INW = 3584, DEPTH = 2, MODW = 9 * DM;
constexpr int ML = NBATCH * SEQ, MC = NBATCH * NCTX, MT = ML + MC;
constexpr float LOG2E = 1.4426950408889634f;
constexpr float QSCALE = 0.088388347648318440f * LOG2E;
constexpr int PC_NQ = 0, PC_NK = 512, PC_NV = 1024, PC_U = 1536, PC_WQ = 2048, PC_WK = 3072, PC_WV = 3328;

constexpr size_t MiB = 1u << 20;
constexpr size_t WS_CTL = 0, CTL_ZERO_BYTES = 1 * MiB;
constexpr size_t WS_MOD = 256 * 1024;
constexpr size_t WS_ROPE = 1 * MiB;
constexpr size_t WS_W = 2 * MiB;
constexpr size_t W_WI1 = 0, W_WO1 = 44 * MiB, W_WIN = 66 * MiB, W_WOUT = 80 * MiB, W_WI2 = 88 * MiB, W_WO2 = 132 * MiB, W_LAYER = 154 * MiB;
constexpr size_t WS_XC = WS_W + 2 * W_LAYER;
constexpr size_t WS_H = WS_XC + 8 * MiB;
constexpr size_t WS_HID = WS_H + 132 * MiB;
constexpr size_t WS_P = WS_HID;
constexpr size_t WS_MIX = WS_HID + 231 * MiB;
constexpr size_t WS_PART = WS_HID + 363 * MiB;
constexpr size_t WS_END = WS_PART + 32 * MiB;
static_assert((size_t)MT * DFF * 2 == 363 * MiB && (size_t)MT * INW * 2 == 231 * MiB && (size_t)MT * DM * 2 == 132 * MiB, "ws map");
static_assert(WS_MOD + (size_t)DEPTH * 5 * MODW * 4 <= CTL_ZERO_BYTES, "MOD inside the zeroed region");
constexpr int CW_BAR = 4096;

constexpr int LDS_BYTES = 147456;
constexpr int LDSCTL_OFF = LDS_BYTES - 512;

__device__ __forceinline__ unsigned f2bf(float f) { unsigned u = __builtin_bit_cast(unsigned, f); return (u + 0x7fffu + ((u >> 16) & 1u)) >> 16; }
__device__ __forceinline__ unsigned cvt_pk_bf16(float lo, float hi) { unsigned r; asm volatile("v_cvt_pk_bf16_f32 %0, %1, %2" : "=v"(r) : "v"(lo), "v"(hi)); return r; }
__device__ __forceinline__ float bf2f(unsigned short b) { return __builtin_bit_cast(float, (unsigned)b << 16); }
__device__ __forceinline__ float wave_sum(float v) {
#pragma unroll
    for (int o = 1; o < 64; o <<= 1) v += __shfl_xor(v, o);
    return v;
}
#define LDS_WAIT() asm volatile("s_waitcnt lgkmcnt(0)" ::: "memory")
#define VM_WAIT() asm volatile("s_waitcnt vmcnt(0)" ::: "memory")

namespace pg8 {
constexpr int BM = 256, BK = 64, HALF = 128, HTB = HALF * BK * 2, STAGE_BYTES = 8 * HTB, NXCD = 8, WGM = 8;
__host__ __device__ __forceinline__ int lds_byte(int r, int c) { const int st = (r >> 4) * 2 + (c >> 5), rr = r & 15, cc = c & 31, ob = rr * 64 + cc * 2; return st * 1024 + (ob ^ (((ob >> 9) & 1) << 5)); }
__host__ __device__ __forceinline__ void stage_rc(int b, int& R, int& C) { const int st = b / 1024, sb = b % 1024, swz = sb ^ (((sb >> 9) & 1) << 5); R = (st >> 1) * 16 + swz / 64; C = (st & 1) * 32 + (swz % 64) / 2; }
__host__ __device__ __forceinline__ int perm32(int rho) { const int n = rho >> 4, i = rho & 15; return 8 * (i >> 2) + 4 * n + (i & 3); }
struct Unit { int pm, pn; unsigned koff; };
struct Gemm { const bf16_t* A; const bf16_t* Bt; int M, N, K, ld; };
struct StaticOrder {
    int nM, nN, nwg, G, c, wgm;
    __host__ __device__ void init(int M, int N, int G_, int c_, int wgm_ = WGM) { nM = M / BM; nN = N / BM; nwg = nM * nN; G = G_; c = c_; wgm = wgm_; }
    __host__ __device__ bool next(int i, Unit& u) const {
        const long L = (long)i * G + c; if (L >= nwg) return false;
        int wgid = (int)L; { const int q = nwg / NXCD, r = nwg % NXCD, xcd = wgid % NXCD, off = wgid / NXCD; wgid = (xcd < r ? xcd * (q + 1) : r * (q + 1) + (xcd - r) * q) + off; }
        const int nig = wgm * nN, gid = wgid / nig, fm = gid * wgm, gsz = (nM - fm) < wgm ? (nM - fm) : wgm;
        u.pm = fm + ((wgid % nig) % gsz); u.pn = (wgid % nig) / gsz; u.koff = 0u; return true;
    }
    __device__ __forceinline__ void a_ready(const Unit&) const {}
    __device__ __forceinline__ void done(const Unit&) const {}
};

struct EpiBf16 {
    static constexpr bool PERM = true, AFTER_DRAIN = false;
    bf16_t* O; int ldc;
    __device__ __forceinline__ void operator()(const f32x4 (&acc)[2][2][4][2], const Unit& u, int wr, int wc, int fr, int fq) const {
        const int row0 = u.pm * BM + wr * 64 + fr, col0 = u.pn * BM + wc * 32 + 8 * fq;
#pragma unroll
        for (int ai = 0; ai < 2; ++ai)
#pragma unroll
            for (int m = 0; m < 4; ++m) { bf16_t* rowp = O + (size_t)(row0 + ai * HALF + m * 16) * ldc + col0;
#pragma unroll
                for (int bj = 0; bj < 2; ++bj) { const f32x4 v0 = acc[ai][bj][m][0], v1 = acc[ai][bj][m][1];
                    u32x4 w; w.x = cvt_pk_bf16(v0[0], v0[1]); w.y = cvt_pk_bf16(v0[2], v0[3]); w.z = cvt_pk_bf16(v1[0], v1[1]); w.w = cvt_pk_bf16(v1[2], v1[3]);
                    *(u32x4*)(rowp + bj * HALF) = w; } }
    }
};
__device__ __forceinline__ float silu_mul(float a, float b) { return a * b * __builtin_amdgcn_rcpf(1.0f + __builtin_amdgcn_exp2f(-a * LOG2E)); }
struct EpiSwiglu {
    static constexpr bool PERM = true, AFTER_DRAIN = false;
    bf16_t* O;
    __device__ __forceinline__ void operator()(const f32x4 (&acc)[2][2][4][2], const Unit& u, int wr, int wc, int fr, int fq) const {
        const int row0 = u.pm * BM + wr * 64 + fr, col0 = u.pn * HALF + wc * 32 + 8 * fq;
#pragma unroll
        for (int ai = 0; ai < 2; ++ai)
#pragma unroll
            for (int m = 0; m < 4; ++m) { bf16_t* rowp = O + (size_t)(row0 + ai * HALF + m * 16) * DFF + col0;
                const f32x4 a0 = acc[ai][0][m][0], a1 = acc[ai][0][m][1], b0 = acc[ai][1][m][0], b1 = acc[ai][1][m][1];
                u32x4 w; w.x = cvt_pk_bf16(silu_mul(a0[0], b0[0]), silu_mul(a0[1], b0[1])); w.y = cvt_pk_bf16(silu_mul(a0[2], b0[2]), silu_mul(a0[3], b0[3]));
                w.z = cvt_pk_bf16(silu_mul(a1[0], b1[0]), silu_mul(a1[1], b1[1])); w.w = cvt_pk_bf16(silu_mul(a1[2], b1[2]), silu_mul(a1[3], b1[3]));
                *(u32x4*)rowp = w; }
    }
};
struct EpiResid {
    static constexpr bool PERM = false, AFTER_DRAIN = false;
    const float* xin_l; const float* xin_c; float* xout_l; float* xout_c; const float* gate; float gs;
    __device__ __forceinline__ void operator()(const f32x4 (&acc)[2][2][4][2], const Unit& u, int wr, int wc, int fr, int fq) const {
        const bool lat = u.pm < (ML / BM); const int s = lat ? (u.pm >> 5) : 4;
        const float* xi = lat ? xin_l + (size_t)u.pm * BM * DM : xin_c + (size_t)(u.pm - ML / BM) * BM * DM;
        float* xo = lat ? xout_l + (size_t)u.pm * BM * DM : xout_c + (size_t)(u.pm - ML / BM) * BM * DM;
        const int r0 = wr * 64 + fr, col0 = u.pn * BM + wc * 32 + 4 * fq;
        const float* gp = gate + (size_t)s * MODW + col0;
#pragma unroll
        for (int bj = 0; bj < 2; ++bj)
#pragma unroll
            for (int n = 0; n < 2; ++n) { const f32x4 gv = *(const f32x4*)(gp + bj * HALF + n * 16) * gs;
#pragma unroll
                for (int ai = 0; ai < 2; ++ai)
#pragma unroll
                    for (int m = 0; m < 4; ++m) { const size_t off = (size_t)(r0 + ai * HALF + m * 16) * DM + col0 + bj * HALF + n * 16;
                        const f32x4 xv = *(const f32x4*)(xi + off); *(f32x4*)(xo + off) = xv + gv * acc[ai][bj][m][n]; } }
    }
};

struct CtxSplitOrder {
    int c; unsigned kq_bytes;
    __device__ bool next(int i, Unit& u) const { if (i != 0 || c >= 128) return false; const int t = c >> 2; u.pm = t & 3; u.pn = t >> 2; u.koff = (unsigned)(c & 3) * kq_bytes; return true; }
    __device__ __forceinline__ void a_ready(const Unit&) const {}
    __device__ __forceinline__ void done(const Unit&) const {}
};
struct EpiPartial {
    static constexpr bool PERM = false, AFTER_DRAIN = false;
    float* part; const float* gate; float gs; unsigned kqb;
    __device__ __forceinline__ void operator()(const f32x4 (&acc)[2][2][4][2], const Unit& u, int wr, int wc, int fr, int fq) const {
        float* xo = part + (size_t)(u.koff / kqb) * MC * DM + (size_t)u.pm * BM * DM;
        const int r0 = wr * 64 + fr, col0 = u.pn * BM + wc * 32 + 4 * fq;
        const float* gp = gate + col0;
#pragma unroll
        for (int bj = 0; bj < 2; ++bj)
#pragma unroll
            for (int n = 0; n < 2; ++n) { const f32x4 gv = *(const f32x4*)(gp + bj * HALF + n * 16) * gs;
#pragma unroll
                for (int ai = 0; ai < 2; ++ai)
#pragma unroll
                    for (int m = 0; m < 4; ++m) *(f32x4*)(xo + (size_t)(r0 + ai * HALF + m * 16) * DM + col0 + bj * HALF + n * 16) = gv * acc[ai][bj][m][n]; }
    }
};

template <class Epi, class Sched, bool ALIGN_EPI = false, bool SP2 = false>
__device__ __forceinline__ void gemm_phase(LAS unsigned char* lds, const Gemm g, const Sched& S, const Epi& E) {
    int tid = threadIdx.x; asm volatile("" : "+v"(tid));
    const int wid = __builtin_amdgcn_readfirstlane(tid >> 6), lane = tid & 63, wr = wid >> 2, wc = wid & 3, fr = lane & 15, fq = lane >> 4;
    const int K = g.ld, nt = g.K / BK;
    unsigned voffA[2], voffB[2];
#pragma unroll
    for (int i = 0; i < 2; ++i) { int R, C; stage_rc(tid * 16 + i * 8192, R, C); const int Rb = Epi::PERM ? ((R & ~31) + perm32(R & 31)) : R;
        voffA[i] = (unsigned)(R * K + C) * 2u; voffB[i] = (unsigned)(Rb * K + C) * 2u; }
    const size_t kstep = (size_t)(BK * 2);
    const size_t hstep = (size_t)HALF * K * 2;
    const size_t tstep = 2 * hstep;
    const unsigned ldsw = (unsigned)wid * 1024u;
    const int aoff = lds_byte(wr * 64 + fr, fq * 8), boff = lds_byte(wc * 32 + fr, fq * 8);
#define PG8_SA(b, h) (((b) * 2 + (h)) * HTB)
#define PG8_SB(b, h) ((4 + (b) * 2 + (h)) * HTB)
#define PG8_STAGE(bufoff, gbase, voff) do { _Pragma("unroll") for (int _i = 0; _i < 2; ++_i) \
        __builtin_amdgcn_global_load_lds((const unsigned*)((const char*)(gbase) + (voff)[_i]), (LAS unsigned*)(lds + (bufoff) + ldsw + _i * 8192), 16, 0, 0); } while (0)
#define PG8_LDA(dst, b, h) do { _Pragma("unroll") for (int m = 0; m < 4; ++m) _Pragma("unroll") for (int k = 0; k < 2; ++k) dst[m][k] = *(const LAS bf16x8*)(lds + PG8_SA(b, h) + aoff + m * 2048 + k * 1024); } while (0)
#define PG8_LDB(dst, b, h) do { _Pragma("unroll") for (int n = 0; n < 2; ++n) _Pragma("unroll") for (int k = 0; k < 2; ++k) dst[n][k] = *(const LAS bf16x8*)(lds + PG8_SB(b, h) + boff + n * 2048 + k * 1024); } while (0)
#define PG8_MMA(ai, bj, At, Bt) do { __builtin_amdgcn_s_setprio(1); _Pragma("unroll") for (int m = 0; m < 4; ++m) _Pragma("unroll") for (int n = 0; n < 2; ++n) _Pragma("unroll") for (int k = 0; k < 2; ++k) \
        acc[ai][bj][m][n] = __builtin_amdgcn_mfma_f32_16x16x32_bf16(Bt[n][k], At[m][k], acc[ai][bj][m][n], 0, 0, 0); __builtin_amdgcn_s_setprio(0); } while (0)
#define PG8_WAIT_V(n) asm volatile("s_waitcnt vmcnt(" #n ")" ::: "memory")
#define PG8_WAIT_L(n) asm volatile("s_waitcnt lgkmcnt(" #n ")" ::: "memory")
#define PG8_BAR __builtin_amdgcn_s_barrier()
#define PG8_SCHED __builtin_amdgcn_sched_barrier(0)
    Unit cur, nxt; int ui = 0;
    if (!S.next(0, cur)) return;
    f32x4 acc[2][2][4][2];
#pragma unroll
    for (int a = 0; a < 2; ++a)
#pragma unroll
        for (int b = 0; b < 2; ++b)
#pragma unroll
            for (int m = 0; m < 4; ++m)
#pragma unroll
                for (int n = 0; n < 2; ++n) acc[a][b][m][n] = (f32x4){0.f, 0.f, 0.f, 0.f};
    bf16x8 At[4][2], B0[2][2], B1[2][2];
    const char* cA = (const char*)g.A + (size_t)cur.pm * tstep + cur.koff; const char* cB = (const char*)g.Bt + (size_t)cur.pn * tstep + cur.koff;
    S.a_ready(cur);
    if constexpr (SP2) {
        PG8_STAGE(PG8_SB(0, 0), cB, voffB); PG8_STAGE(PG8_SB(0, 1), cB + hstep, voffB); PG8_STAGE(PG8_SA(0, 0), cA, voffA); PG8_STAGE(PG8_SA(0, 1), cA + hstep, voffA);
        if (wr == 1) PG8_BAR;
        PG8_WAIT_V(2); PG8_BAR;
        PG8_STAGE(PG8_SB(1, 0), cB + kstep, voffB); PG8_STAGE(PG8_SA(1, 0), cA + kstep, voffA); PG8_STAGE(PG8_SB(1, 1), cB + hstep + kstep, voffB);
        PG8_WAIT_V(6); PG8_BAR;
    } else {
        PG8_STAGE(PG8_SB(0, 0), cB, voffB); PG8_STAGE(PG8_SA(0, 0), cA, voffA); PG8_STAGE(PG8_SB(0, 1), cB + hstep, voffB); PG8_STAGE(PG8_SA(0, 1), cA + hstep, voffA);
        if (wr == 1) PG8_BAR;
        PG8_WAIT_V(4); PG8_BAR;
        PG8_STAGE(PG8_SB(1, 0), cB + kstep, voffB); PG8_STAGE(PG8_SA(1, 0), cA + kstep, voffA); PG8_STAGE(PG8_SB(1, 1), cB + hstep + kstep, voffB);
        PG8_WAIT_V(6); PG8_BAR;
    }
    for (;;) {
        const bool has_next = S.next(ui + 1, nxt);
        const char* nA = has_next ? (const char*)g.A + (size_t)nxt.pm * tstep + nxt.koff : cA; const char* nB = has_next ? (const char*)g.Bt + (size_t)nxt.pn * tstep + nxt.koff : cB;
        for (int t = 0; t < nt; t += 2) {
            const bool last = (t == nt - 2);
            const char* a1 = cA + (size_t)(t + 1) * kstep;
            const char* a2 = last ? nA : cA + (size_t)(t + 2) * kstep; const char* b2 = last ? nB : cB + (size_t)(t + 2) * kstep;
            const char* a3 = a2 + kstep; const char* b3 = b2 + kstep;
            if (last && has_next) S.a_ready(nxt);
            if constexpr (SP2) {
            PG8_LDB(B0, 0, 0); PG8_LDB(B1, 0, 1); PG8_SCHED; PG8_LDA(At, 0, 0); PG8_STAGE(PG8_SA(1, 1), a1 + hstep, voffA);
            PG8_WAIT_V(8); PG8_WAIT_L(0); PG8_BAR; PG8_MMA(0, 0, At, B0); PG8_MMA(0, 1, At, B1); PG8_BAR; PG8_SCHED;
            PG8_LDA(At, 0, 1); PG8_STAGE(PG8_SB(0, 0), b2, voffB); PG8_STAGE(PG8_SB(0, 1), b2 + hstep, voffB); PG8_STAGE(PG8_SA(0, 0), a2, voffA);
            PG8_WAIT_V(8); PG8_WAIT_L(0); PG8_BAR; PG8_MMA(1, 0, At, B0); PG8_MMA(1, 1, At, B1); PG8_BAR; PG8_SCHED;
            PG8_LDB(B0, 1, 0); PG8_LDB(B1, 1, 1); PG8_SCHED; PG8_LDA(At, 1, 0); PG8_STAGE(PG8_SA(0, 1), a2 + hstep, voffA);
            PG8_WAIT_V(8); PG8_WAIT_L(0); PG8_BAR; PG8_MMA(0, 0, At, B0); PG8_MMA(0, 1, At, B1); PG8_BAR; PG8_SCHED;
            PG8_LDA(At, 1, 1); PG8_STAGE(PG8_SB(1, 0), b3, voffB); PG8_STAGE(PG8_SB(1, 1), b3 + hstep, voffB); PG8_STAGE(PG8_SA(1, 0), a3, voffA);
            PG8_WAIT_V(8); PG8_WAIT_L(0); PG8_BAR; PG8_MMA(1, 0, At, B0); PG8_MMA(1, 1, At, B1); PG8_BAR; PG8_SCHED;
            } else {
            PG8_LDB(B0, 0, 0); PG8_SCHED; PG8_LDA(At, 0, 0); PG8_STAGE(PG8_SA(1, 1), a1 + hstep, voffA);
            PG8_WAIT_L(8); PG8_BAR; PG8_WAIT_L(0); PG8_MMA(0, 0, At, B0); PG8_BAR; PG8_SCHED;
            PG8_LDB(B1, 0, 1); PG8_STAGE(PG8_SB(0, 0), b2, voffB);
            PG8_BAR; PG8_WAIT_L(0); PG8_MMA(0, 1, At, B1); PG8_BAR;
            PG8_LDA(At, 0, 1); PG8_STAGE(PG8_SA(0, 0), a2, voffA);
            PG8_BAR; PG8_WAIT_L(0); PG8_MMA(1, 0, At, B0); PG8_BAR; PG8_SCHED;
            PG8_STAGE(PG8_SB(0, 1), b2 + hstep, voffB);
            PG8_WAIT_V(6); PG8_BAR; PG8_MMA(1, 1, At, B1); PG8_BAR;
            PG8_LDB(B0, 1, 0); PG8_SCHED; PG8_LDA(At, 1, 0); PG8_STAGE(PG8_SA(0, 1), a2 + hstep, voffA);
            PG8_WAIT_L(8); PG8_BAR; PG8_WAIT_L(0); PG8_MMA(0, 0, At, B0); PG8_BAR; PG8_SCHED;
            PG8_LDB(B1, 1, 1); PG8_STAGE(PG8_SB(1, 0), b3, voffB);
            PG8_BAR; PG8_WAIT_L(0); PG8_MMA(0, 1, At, B1); PG8_BAR;
            PG8_LDA(At, 1, 1); PG8_STAGE(PG8_SA(1, 0), a3, voffA);
            PG8_BAR; PG8_WAIT_L(0); PG8_MMA(1, 0, At, B0); PG8_BAR; PG8_SCHED;
            PG8_STAGE(PG8_SB(1, 1), b3 + hstep, voffB);
            PG8_WAIT_V(6); PG8_BAR; PG8_MMA(1, 1, At, B1); PG8_BAR;
            }
        }
        if constexpr (ALIGN_EPI) { if (wr == 0) PG8_BAR; }
        if constexpr (!Epi::AFTER_DRAIN) { E(acc, cur, wr, wc, fr, fq); S.done(cur); }
        if (!has_next) break;
#pragma unroll
        for (int a = 0; a < 2; ++a)
#pragma unroll
            for (int b = 0; b < 2; ++b)
#pragma unroll
                for (int m = 0; m < 4; ++m)
#pragma unroll
                    for (int n = 0; n < 2; ++n) acc[a][b][m][n] = (f32x4){0.f, 0.f, 0.f, 0.f};
        cur = nxt; cA = nA; cB = nB; ++ui;
        if constexpr (ALIGN_EPI) { if (wr == 1) PG8_BAR; }
    }
    PG8_WAIT_V(0);
    if constexpr (!ALIGN_EPI) { if (wr == 0) PG8_BAR; }
    PG8_BAR;
#undef PG8_SA
#undef PG8_SB
#undef PG8_STAGE
#undef PG8_LDA
#undef PG8_LDB
#undef PG8_MMA
#undef PG8_WAIT_V
#undef PG8_WAIT_L
#undef PG8_BAR
#undef PG8_SCHED
}
}

namespace att {
constexpr int SHM_V = 64 * 128 * 2, SHM_K = SHM_V;
constexpr int OFF_V = 0, OFF_K = 2 * SHM_V, OFF_WS = 4 * SHM_V, OFF_OST = OFF_WS + 2048, OST_WAVE = 32 * 272, OFF_RPB = OFF_OST + 8 * OST_WAVE, ATT_LDS_END = OFF_RPB + 2048;
static_assert(ATT_LDS_END <= LDSCTL_OFF, "attention LDS map");
constexpr float THR = 11.5f;
#define KSWZ(row, colB) ((row) * 256 + ((colB) ^ (((row) & 7) << 4)))
#define SBAR() __builtin_amdgcn_sched_barrier(0)
__device__ __forceinline__ int crow(int r, int hi) { return (r & 3) + 8 * (r >> 2) + 4 * hi; }
__device__ __forceinline__ void partialSM(f32x16& p0, f32x16& p1, float& m_reg, float& mn, float& alpha) {
    float pmax = p0[0];
#pragma unroll
    for (int r = 1; r < 16; ++r) pmax = fmaxf(pmax, p0[r]);
#pragma unroll
    for (int r = 0; r < 16; ++r) pmax = fmaxf(pmax, p1[r]);
    { auto rr = __builtin_amdgcn_permlane32_swap(__float_as_uint(pmax), __float_as_uint(pmax), false, false);
      pmax = fmaxf(__uint_as_float(rr[0]), __uint_as_float(rr[1])); }
    if (__builtin_expect(__all(pmax - m_reg <= THR), 1)) { mn = m_reg; alpha = 1.f; }
    else { mn = fmaxf(m_reg, pmax); alpha = __builtin_amdgcn_exp2f(m_reg - mn); m_reg = mn; }
#pragma unroll
    for (int r = 0; r < 16; ++r) p0[r] = p0[r] - mn;
#pragma unroll
    for (int r = 0; r < 16; ++r) p1[r] = p1[r] - mn;
#pragma unroll
    for (int r = 0; r < 16; ++r) p0[r] = __builtin_amdgcn_exp2f(p0[r]);
}
__device__ __forceinline__ void finishSM(f32x16& p0, f32x16& p1, float alpha, float& l_reg, bf16x8& pa0, bf16x8& pa1, bf16x8& pa2, bf16x8& pa3) {
#pragma unroll
    for (int r = 0; r < 16; ++r) p1[r] = __builtin_amdgcn_exp2f(p1[r]);
    float ps = 0;
#pragma unroll
    for (int r = 0; r < 16; ++r) ps += p0[r];
#pragma unroll
    for (int r = 0; r < 16; ++r) ps += p1[r];
    { auto rr = __builtin_amdgcn_permlane32_swap(__float_as_uint(ps), __float_as_uint(ps), false, false);
      ps = __uint_as_float(rr[0]) + __uint_as_float(rr[1]); }
    l_reg = l_reg * alpha + ps;
#define PK4(P, BASE, OUT) do { unsigned a0 = cvt_pk_bf16(P[BASE + 0], P[BASE + 1]), a1 = cvt_pk_bf16(P[BASE + 2], P[BASE + 3]);   \
    unsigned b0 = cvt_pk_bf16(P[BASE + 4], P[BASE + 5]), b1 = cvt_pk_bf16(P[BASE + 6], P[BASE + 7]);                              \
    auto r0 = __builtin_amdgcn_permlane32_swap(a0, b0, false, false); auto r1 = __builtin_amdgcn_permlane32_swap(a1, b1, false, false); \
    u32x4 w = {r0[0], r1[0], r0[1], r1[1]}; OUT = __builtin_bit_cast(bf16x8, w); } while (0)
    PK4(p0, 0, pa0); PK4(p0, 8, pa1); PK4(p1, 0, pa2); PK4(p1, 8, pa3);
#undef PK4
}
__device__ __forceinline__ void qkt(f32x16& p0, f32x16& p1, const LAS char* Ks, const bf16x8* qr, int r32, int hi) {
    p0 = f32x16{}; p1 = f32x16{};
#pragma unroll
    for (int d0 = 0; d0 < 8; ++d0) { const int cb = (d0 * 16 + hi * 8) * 2;
        const bf16x8 b0 = *(const LAS bf16x8*)(Ks + KSWZ(r32, cb));
        const bf16x8 b1 = *(const LAS bf16x8*)(Ks + KSWZ(32 + r32, cb));
        p0 = __builtin_amdgcn_mfma_f32_32x32x16_bf16(b0, qr[d0], p0, 0, 0, 0);
        p1 = __builtin_amdgcn_mfma_f32_32x32x16_bf16(b1, qr[d0], p1, 0, 0, 0); }
}
__device__ __forceinline__ int v_st(int k, int c) { const int kk = (k & ~0xC) | ((k & 4) << 1) | ((k & 8) >> 1); return ((kk >> 3) * 4 + (c >> 5)) * 512 + ((kk & 7) * 32 + (c & 31)) * 2; }
__device__ __forceinline__ int v_rd_base(int lane) { return ((lane & 3) << 3) | (((lane >> 2) & 3) << 6) | (((lane >> 4) & 1) << 5) | (((lane >> 5) & 1) << 8); }
constexpr int v_rd_off(int d0, int ks, int half) { return d0 * 512 + ks * 4096 + half * 2048; }
template <int OFF> __device__ __forceinline__ s16x4 tr_read(int vb) {
    s16x4 r; asm volatile("ds_read_b64_tr_b16 %0, %1 offset:%2" : "=&v"(r) : "v"(vb), "i"(OFF) : "memory"); return r;
}
template <int D0> __device__ __forceinline__ void pv_one(f32x16& od, int vb, bf16x8 pa0, bf16x8 pa1, bf16x8 pa2, bf16x8 pa3) {
    const s16x4 l0 = tr_read<v_rd_off(D0, 0, 0)>(vb), h0 = tr_read<v_rd_off(D0, 0, 1)>(vb), l1 = tr_read<v_rd_off(D0, 1, 0)>(vb), h1 = tr_read<v_rd_off(D0, 1, 1)>(vb);
    const s16x4 l2 = tr_read<v_rd_off(D0, 2, 0)>(vb), h2 = tr_read<v_rd_off(D0, 2, 1)>(vb), l3 = tr_read<v_rd_off(D0, 3, 0)>(vb), h3 = tr_read<v_rd_off(D0, 3, 1)>(vb);
    asm volatile("s_waitcnt lgkmcnt(0)" ::: "memory"); SBAR();
#define PK(L, H) (bf16x8){L[0], L[1], L[2], L[3], H[0], H[1], H[2], H[3]}
    od = __builtin_amdgcn_mfma_f32_32x32x16_bf16(pa0, PK(l0, h0), od, 0, 0, 0);
    od = __builtin_amdgcn_mfma_f32_32x32x16_bf16(pa1, PK(l1, h1), od, 0, 0, 0);
    od = __builtin_amdgcn_mfma_f32_32x32x16_bf16(pa2, PK(l2, h2), od, 0, 0, 0);
    od = __builtin_amdgcn_mfma_f32_32x32x16_bf16(pa3, PK(l3, h3), od, 0, 0, 0);
#undef PK
}
__device__ __forceinline__ void pv_d0(f32x16* o, int vb, bf16x8 pa0, bf16x8 pa1, bf16x8 pa2, bf16x8 pa3) {
    pv_one<0>(o[0], vb, pa0, pa1, pa2, pa3); pv_one<1>(o[1], vb, pa0, pa1, pa2, pa3); pv_one<2>(o[2], vb, pa0, pa1, pa2, pa3); pv_one<3>(o[3], vb, pa0, pa1, pa2, pa3);
}

struct Mask { int kind, nb, jlo, pq  , rk0, qr, qc  ; const LAS float* rpb; };
__device__ __forceinline__ void apply_mask(f32x16& p0, f32x16& p1, const Mask& M, int t, int hi) {
    if (t >= M.nb) return;
    const float NEG = -__builtin_inff();
#define CR(r) (((r) & 3) + 8 * ((r) >> 2))
    if (M.kind == 0) {
        const int jt = M.jlo + t;
        if (jt < 2) { const int lim = M.pq - 64 * jt - 4 * hi;
#pragma unroll
            for (int r = 0; r < 16; ++r) { p0[r] = (CR(r) >= lim) ? p0[r] : NEG; p1[r] = (CR(r) + 32 >= lim) ? p1[r] : NEG; }
        } else if (jt >= 4) { const int lim = M.pq - 64 * (jt - 4) - 4 * hi;
#pragma unroll
            for (int r = 0; r < 16; ++r) { p0[r] = (CR(r) <= lim) ? p0[r] : NEG; p1[r] = (CR(r) + 32 <= lim) ? p1[r] : NEG; }
        }
    } else if (M.kind == 1) {
        const int kr = M.rk0 + t; int r0q = M.qr - 4; r0q = r0q < 0 ? 0 : (r0q > 120 ? 120 : r0q);
        const bool rowok = (kr >= r0q) && (kr < r0q + 8);
        int dr = kr - M.qr + 7; dr = dr < 0 ? 0 : (dr > 14 ? 14 : dr);
        int c0 = M.qc - 8; c0 = c0 < 0 ? 0 : (c0 > 48 ? 48 : c0);
        const int c0h = rowok ? (c0 - 4 * hi) : 1000;
        const LAS float* tb = M.rpb + dr * 31 + (15 - M.qc) + 4 * hi;
#pragma unroll
        for (int r = 0; r < 16; ++r) { const float b0 = tb[CR(r)]; p0[r] = ((unsigned)(CR(r) - c0h) < 16u) ? p0[r] + b0 : NEG; }
        SBAR();
#pragma unroll
        for (int r = 0; r < 16; ++r) { const float b1 = tb[CR(r) + 32]; p1[r] = ((unsigned)(CR(r) + 32 - c0h) < 16u) ? p1[r] + b1 : NEG; }
    }
#undef CR
}

__device__ __forceinline__ void attn_unit(const bf16_t* __restrict__ P, bf16_t* __restrict__ MIX, const float* __restrict__ sinkp, const float* __restrict__ rpbp,
                                          int kind, int b, int i1, int i2, LAS char* lds) {
    int tid = threadIdx.x; asm volatile("" : "+v"(tid));
    const int wid = __builtin_amdgcn_readfirstlane(tid >> 6), lane = tid & 63, r32 = lane & 31, hi = lane >> 5;
    LAS char* V_lds = lds + OFF_V; LAS char* K_lds = lds + OFF_K;
    LAS float* wsf = (LAS float*)(lds + OFF_WS) + wid * 64; LAS float* li_l = wsf; LAS float* al_l = wsf + 32;
    LAS float* rpb_l = (LAS float*)(lds + OFF_RPB);
    int qbase, qcol, ocol, nb, row0, kcol, vcol; float sink2 = -__builtin_inff();
    Mask MK; MK.kind = kind; MK.jlo = 0; MK.pq = 0; MK.rk0 = 0; MK.qr = 0; MK.qc = 0; MK.rpb = rpb_l;
    if (kind == 0) {
        const int n = i1, kvh = i2 >> 1, gp = i2 & 1, g = 2 * gp + (wid >> 2), qh = 4 * kvh + g, p0q = 32 * (wid & 3);
        qbase = b * SEQ + n * 128 + p0q; qcol = PC_WQ + qh * 128; ocol = 1024 + qh * 128;
        const int jlo = (n == 0) ? 2 : 0, jhi = (n == SEQ / 128 - 1) ? 4 : 6; nb = jhi - jlo; row0 = b * SEQ + (n - 1) * 128 + 64 * jlo;
        kcol = PC_WK + kvh * 128; vcol = PC_WV + kvh * 128; sink2 = sinkp[qh] * LOG2E;
        MK.jlo = jlo; MK.pq = p0q + r32;
    } else if (kind == 1) {
        const int r = 4 * i1, h = i2, qr = r + (wid >> 1), c32 = 32 * (wid & 1);
        qbase = b * SEQ + qr * 64 + c32; qcol = PC_NQ + h * 128; ocol = h * 128;
        int rk0 = r - 4; rk0 = rk0 < 0 ? 0 : (rk0 > 116 ? 116 : rk0); nb = 12; row0 = b * SEQ + rk0 * 64;
        kcol = PC_NK + h * 128; vcol = PC_NV + h * 128;
        MK.rk0 = rk0; MK.qr = qr; MK.qc = c32 + r32;
        if (tid < 15 * 31) rpb_l[tid] = rpbp[h * (15 * 31) + tid] * LOG2E;
    } else if (kind == 2) {
        const int h = i1; qbase = ML + b * NCTX + 32 * wid; qcol = PC_NQ + h * 128; ocol = h * 128; nb = 0; row0 = 0; kcol = PC_NK + h * 128; vcol = PC_NV + h * 128;
    } else {
        const int qh = i1, kvh = qh >> 2; qbase = ML + b * NCTX + 32 * wid; qcol = PC_WQ + qh * 128; ocol = 1024 + qh * 128; nb = 0; row0 = 0;
        kcol = PC_WK + kvh * 128; vcol = PC_WV + kvh * 128; sink2 = sinkp[qh] * LOG2E;
    }
    MK.nb = nb;
    const int crow0 = ML + b * NCTX, NT = nb + 4;
    float m_reg = -1e30f, l_reg = 0; f32x16 o[4] = {}; bf16x8 qr[8];
    { const bf16_t* Qw = P + (size_t)(qbase + r32) * INW + qcol + hi * 8;
#pragma unroll
      for (int d0 = 0; d0 < 8; ++d0) qr[d0] = *(const bf16x8*)(Qw + d0 * 16); }
    const int sr = tid >> 4, sc = (tid & 15) * 8, vst0 = v_st(sr, sc), vst1 = v_st(32 + sr, sc);
    const int vb0 = (int)(unsigned)(size_t)V_lds + v_rd_base(lane);
#define TROW(t) (((t) < nb) ? (row0 + 64 * (t)) : (crow0 + 64 * ((t) - nb)))
#define RESC(a) do { if (__any((a) < 1.f)) { if (hi == 0) al_l[r32] = (a); asm volatile("s_waitcnt lgkmcnt(0)" ::: "memory"); \
    _Pragma("unroll") for (int d = 0; d < 4; ++d) _Pragma("unroll") for (int r = 0; r < 16; ++r) o[d][r] *= al_l[crow(r, hi)]; } } while (0)
#if ATT_PIPE2
    struct { bf16x8 vs0, vs1, ks0, ks1; } sr_[2];
#define SLOAD(i, t) do { const bf16_t* _b = P + (size_t)(TROW(t) + sr) * INW + sc; \
    sr_[i].vs0 = *(const bf16x8*)(_b + vcol); sr_[i].vs1 = *(const bf16x8*)(_b + (size_t)32 * INW + vcol); \
    sr_[i].ks0 = *(const bf16x8*)(_b + kcol); sr_[i].ks1 = *(const bf16x8*)(_b + (size_t)32 * INW + kcol); } while (0)
#define SWRITE(bb, i) do { *(LAS bf16x8*)(V_lds + (bb) * SHM_V + vst0) = sr_[i].vs0; *(LAS bf16x8*)(V_lds + (bb) * SHM_V + vst1) = sr_[i].vs1; const int kc_ = sc * 2; \
    *(LAS bf16x8*)(K_lds + (bb) * SHM_K + KSWZ(sr, kc_)) = sr_[i].ks0; *(LAS bf16x8*)(K_lds + (bb) * SHM_K + KSWZ(32 + sr, kc_)) = sr_[i].ks1; } while (0)
#define SWAIT() asm volatile("s_waitcnt vmcnt(4)" ::: "memory")
    f32x16 pA0, pA1, pB0, pB1; float mnA, mnB, alA, alB; bf16x8 pa0, pa1, pa2, pa3;
    constexpr int SE = 0, SO = 1;
    SLOAD(SE, 0); asm volatile("s_waitcnt vmcnt(0)" ::: "memory"); SWRITE(0, SE); __syncthreads();
    qkt(pA0, pA1, K_lds, qr, r32, hi); apply_mask(pA0, pA1, MK, 0, hi); partialSM(pA0, pA1, m_reg, mnA, alA);
    SLOAD(SO, 1); if (2 < NT) SLOAD(SE, 2);
    SWAIT(); SWRITE(1, SO); __syncthreads();
    for (int j = 1; j + 1 < NT; j += 2) {
        SBAR(); qkt(pB0, pB1, K_lds + SHM_K, qr, r32, hi);
        finishSM(pA0, pA1, alA, l_reg, pa0, pa1, pa2, pa3); SBAR();
        SLOAD(SO, j + 2); SBAR();
        pv_d0(o, vb0, pa0, pa1, pa2, pa3); apply_mask(pB0, pB1, MK, j, hi); partialSM(pB0, pB1, m_reg, mnB, alB);
        __syncthreads(); SWAIT(); SWRITE(0, SE);
        RESC(alB); __syncthreads();
        SBAR(); qkt(pA0, pA1, K_lds, qr, r32, hi);
        finishSM(pB0, pB1, alB, l_reg, pa0, pa1, pa2, pa3); SBAR();
        if (j + 3 < NT) SLOAD(SE, j + 3); SBAR();
        pv_d0(o, vb0 + SHM_V, pa0, pa1, pa2, pa3); apply_mask(pA0, pA1, MK, j + 1, hi); partialSM(pA0, pA1, m_reg, mnA, alA);
        __syncthreads(); SWAIT(); SWRITE(1, SO);
        RESC(alA); __syncthreads();
    }
    SBAR(); qkt(pB0, pB1, K_lds + SHM_K, qr, r32, hi);
    finishSM(pA0, pA1, alA, l_reg, pa0, pa1, pa2, pa3); SBAR();
    pv_d0(o, vb0, pa0, pa1, pa2, pa3); apply_mask(pB0, pB1, MK, NT - 1, hi); partialSM(pB0, pB1, m_reg, mnB, alB);
    __syncthreads(); RESC(alB);
    finishSM(pB0, pB1, alB, l_reg, pa0, pa1, pa2, pa3); SBAR();
    pv_d0(o, vb0 + SHM_V, pa0, pa1, pa2, pa3);
#undef SWAIT
#else
    bf16x8 vs0, vs1, ks0, ks1;
#define SLOAD(t) do { const bf16_t* _b = P + (size_t)(TROW(t) + sr) * INW + sc; \
    vs0 = *(const bf16x8*)(_b + vcol); vs1 = *(const bf16x8*)(_b + (size_t)32 * INW + vcol); \
    ks0 = *(const bf16x8*)(_b + kcol); ks1 = *(const bf16x8*)(_b + (size_t)32 * INW + kcol); } while (0)
#define SWRITE(bb) do { *(LAS bf16x8*)(V_lds + (bb) * SHM_V + vst0) = vs0; *(LAS bf16x8*)(V_lds + (bb) * SHM_V + vst1) = vs1; const int kc_ = sc * 2; \
    *(LAS bf16x8*)(K_lds + (bb) * SHM_K + KSWZ(sr, kc_)) = ks0; *(LAS bf16x8*)(K_lds + (bb) * SHM_K + KSWZ(32 + sr, kc_)) = ks1; } while (0)
    SLOAD(0); asm volatile("s_waitcnt vmcnt(0)" ::: "memory"); SWRITE(0); SLOAD(1); __syncthreads();
    for (int j = 0; j < NT; ++j) {
        const int bsel = j & 1;
        f32x16 p0, p1; float mn, al; bf16x8 pa0, pa1, pa2, pa3;
        qkt(p0, p1, K_lds + bsel * SHM_K, qr, r32, hi);
        apply_mask(p0, p1, MK, j, hi);
        partialSM(p0, p1, m_reg, mn, al);
        RESC(al);
        finishSM(p0, p1, al, l_reg, pa0, pa1, pa2, pa3);
        pv_d0(o, vb0 + bsel * SHM_V, pa0, pa1, pa2, pa3);
        if (j + 1 < NT) { asm volatile("s_waitcnt vmcnt(0)" ::: "memory"); SWRITE(bsel ^ 1); if (j + 2 < NT) SLOAD(j + 2); }
        __syncthreads();
    }
#endif
    l_reg += __builtin_amdgcn_exp2f(sink2 - m_reg);
    if (hi == 0) li_l[r32] = l_reg; asm volatile("s_waitcnt lgkmcnt(0)" ::: "memory");
    LAS char* ost = lds + OFF_OST + wid * OST_WAVE;
#pragma unroll
    for (int r = 0; r < 16; ++r) { const int orow = crow(r, hi); const float rl = __builtin_amdgcn_rcpf(li_l[orow]);
#pragma unroll
        for (int d0 = 0; d0 < 4; ++d0) *(LAS unsigned short*)(ost + orow * 272 + (d0 * 32 + r32) * 2) = (unsigned short)f2bf(o[d0][r] * rl); }
    asm volatile("s_waitcnt lgkmcnt(0)" ::: "memory");
#pragma unroll
    for (int i = 0; i < 8; ++i) { const int id = i * 64 + lane, rr = id >> 4, c16 = id & 15;
        const u32x4 v = *(const LAS u32x4*)(ost + rr * 272 + c16 * 16);
        *(u32x4*)(MIX + (size_t)(qbase + rr) * DM + ocol + c16 * 8) = v; }
#undef TROW
#undef SLOAD
#undef SWRITE
#undef RESC
}
}

#define XB_TMO      128
#define XB_XCNT(j)  (256  + 64 * (j))
#define XB_XSUB(j)  (1280 + 64 * (j))
#define XB_XGEN(j)  (2304 + 64 * (j))
#define XB_TOP      3328
#define XB_TOPGEN   3392
#define XCD_BAR_WORDS 3456
#define XB_SPIN_CAP (1u << 18)
__device__ __forceinline__ unsigned xb_ld(unsigned* p)              { return __hip_atomic_load(p, __ATOMIC_RELAXED, __HIP_MEMORY_SCOPE_AGENT); }
__device__ __forceinline__ unsigned xb_add(unsigned* p, unsigned v) { return __hip_atomic_fetch_add(p, v, __ATOMIC_RELAXED, __HIP_MEMORY_SCOPE_AGENT); }
__device__ __forceinline__ unsigned xb_xcc_id() { return (unsigned)__builtin_amdgcn_s_getreg((3 << 11) | 20) & 0xFu; }
#define XB_SPIN(cond, bar) do { unsigned _sp = 0; while (cond) { __builtin_amdgcn_s_sleep(1); \
    if ((++_sp & 255u) == 0u) { if (xb_ld(&(bar)[XB_TMO])) break; if (_sp > XB_SPIN_CAP) { atomicAdd(&(bar)[XB_TMO], 1u); break; } } } } while (0)
struct XcdBarrier { unsigned* bar; unsigned x; volatile LAS unsigned* st; };
__device__ __forceinline__ XcdBarrier xcd_barrier_post(unsigned* bar, volatile LAS unsigned* st) {
    XcdBarrier b; b.bar = bar; b.x = xb_xcc_id(); b.st = st;
    if (threadIdx.x == 0) (void)xb_add(&bar[XB_XCNT(b.x)], 1u);
    return b;
}
__device__ __forceinline__ void xcd_barrier_complete(unsigned* bar, unsigned x, unsigned& nloc, unsigned& nx) {
    const unsigned G = gridDim.x * gridDim.y * gridDim.z;
    unsigned sum, cnt, mine, sp = 0u;
    for (;;) {
        sum = 0u; cnt = 0u; mine = 0u;
#pragma unroll
        for (unsigned j = 0; j < 16; ++j) { const unsigned c = xb_ld(&bar[XB_XCNT(j)]); sum += c; cnt += (c > 0u) ? 1u : 0u; mine = (j == x) ? c : mine; }
        if (sum == G) break;
        __builtin_amdgcn_s_sleep(1);
        if ((++sp & 255u) == 0u) { if (xb_ld(&bar[XB_TMO])) break; if (sp > XB_SPIN_CAP) { atomicAdd(&bar[XB_TMO], 1u); break; } }
    }
    nloc = mine > 0u ? mine : 1u; nx = cnt > 0u ? cnt : 1u;
}
__device__ __forceinline__ void xcd_barrier(const XcdBarrier& b) {
    asm volatile("s_waitcnt vmcnt(0)" ::: "memory");
    __syncthreads();
    if (threadIdx.x == 0) {
        unsigned* bar = b.bar;
        __builtin_amdgcn_s_waitcnt(0);
        unsigned nloc = b.st[0], nx = b.st[1];
        if (nloc == 0u) { xcd_barrier_complete(bar, b.x, nloc, nx); b.st[0] = nloc; b.st[1] = nx; }
        const unsigned old = xb_add(&bar[XB_XSUB(b.x)], 1u);
        const unsigned gen = old / nloc;
        if (old + 1u == (gen + 1u) * nloc) {
            __builtin_amdgcn_fence(__ATOMIC_RELEASE, "agent");
            asm volatile("s_waitcnt vmcnt(0)" ::: "memory");
            const unsigned og = xb_add(&bar[XB_TOP], 1u);
            const unsigned tg = og / nx;
            if (og + 1u == (tg + 1u) * nx) xb_add(&bar[XB_TOPGEN], 1u);
            else XB_SPIN(xb_ld(&bar[XB_TOPGEN]) == tg, bar);
            __builtin_amdgcn_fence(__ATOMIC_ACQUIRE, "agent");
            xb_add(&bar[XB_XGEN(b.x)], 1u);
            asm volatile("s_waitcnt vmcnt(0)" ::: "memory");
        } else {
            XB_SPIN(xb_ld(&bar[XB_XGEN(b.x)]) == gen, bar);
            __builtin_amdgcn_fence(__ATOMIC_ACQUIRE, "agent");
            asm volatile("s_waitcnt vmcnt(0)" ::: "memory");
        }
    }
    __syncthreads();
}

__device__ __forceinline__ int wt_dest_row(int n0, int N, bool swiglu) {
    if (!swiglu) return n0;
    const int half = N / 2; const int j = (n0 < half) ? n0 : n0 - half; return 256 * (j >> 7) + (j & 127) + ((n0 < half) ? 0 : 128);
}
__device__ __forceinline__ void transpose_item(const float* __restrict__ W, int K, int N, bf16_t* __restrict__ WT, bool swiglu, int item, int lane) {
    const int nblk = N / 64, kb = item / nblk, nbi = item - kb * nblk, k0 = 64 * kb, n0 = 64 * nbi;
    const int k8 = lane & 7, n4 = lane >> 3;
    const float* src = W + (size_t)(k0 + 8 * k8) * N + n0 + 4 * n4;
    f32x4 v[2][8];
#pragma unroll
    for (int h = 0; h < 2; ++h)
#pragma unroll
        for (int i = 0; i < 8; ++i) v[h][i] = __builtin_nontemporal_load((const f32x4*)(src + (size_t)i * N + 32 * h));
#pragma unroll
    for (int h = 0; h < 2; ++h) { const int d0 = wt_dest_row(n0 + 32 * h, N, swiglu);
        bf16_t* dst = WT + (size_t)(d0 + 4 * n4) * K + k0 + 8 * k8;
#pragma unroll
        for (int j = 0; j < 4; ++j) { u32x4 o; o.x = cvt_pk_bf16(v[h][0][j], v[h][1][j]); o.y = cvt_pk_bf16(v[h][2][j], v[h][3][j]); o.z = cvt_pk_bf16(v[h][4][j], v[h][5][j]); o.w = cvt_pk_bf16(v[h][6][j], v[h][7][j]);
            *(u32x4*)(dst + (size_t)j * K) = o; } }
}
__device__ __forceinline__ float silu_f(float x) { return x / (1.0f + __expf(-x)); }
__device__ __forceinline__ void sincos_small(float a, float& c, float& s) {
    const float n = rintf(a * 0.63661977236758134f);
    float r = fmaf(-n, 1.57079637050628662109375f, a); r = fmaf(n, 4.37113900018624283e-8f, r);
    const float z = r * r;
    const float sp = r + r * z * (-1.6666654611e-1f + z * (8.3321608736e-3f + z * (-1.9515295891e-4f)));
    const float cp = 1.0f - 0.5f * z + z * z * (4.166664568298827e-2f + z * (-1.388731625493765e-3f + z * 2.443315711809948e-5f));
    const int q = ((int)n) & 3;
    c = (q == 0) ? cp : (q == 1) ? -sp : (q == 2) ? -cp : sp;
    s = (q == 0) ? sp : (q == 1) ? cp : (q == 2) ? -sp : -cp;
}

__device__ __forceinline__ void norm_phase(const float* xl, const float* xc, float* xcw, const float* part, const float* g, const float* modl, int shift_chunk, int scale_chunk, bf16_t* H, int nrows, int gw, int ngw, int lane) {
    for (int row = gw; row < nrows; row += ngw) {
        const float* xr = (row < ML) ? xl + (size_t)row * DM : xc + (size_t)(row - ML) * DM;
        const int s = (row < ML) ? (row >> 13) : 4;
        const f32x4* sh = (const f32x4*)(modl + (size_t)s * MODW + shift_chunk * DM); const f32x4* scp = (const f32x4*)(modl + (size_t)s * MODW + scale_chunk * DM);
        f32x4 v[8]; float ss = 0.f;
#pragma unroll
        for (int j = 0; j < 8; ++j) v[j] = ((const f32x4*)xr)[lane + 64 * j];
        if (part != nullptr && row >= ML) {
            const f32x4* pp = (const f32x4*)(part + (size_t)(row - ML) * DM);
#pragma unroll
            for (int j = 0; j < 8; ++j) { v[j] += (pp[lane + 64 * j] + pp[(size_t)MC * DM / 4 + lane + 64 * j]) + (pp[(size_t)2 * MC * DM / 4 + lane + 64 * j] + pp[(size_t)3 * MC * DM / 4 + lane + 64 * j]);
                ((f32x4*)(xcw + (size_t)(row - ML) * DM))[lane + 64 * j] = v[j]; }
        }
#pragma unroll
        for (int j = 0; j < 8; ++j) ss += (v[j].x * v[j].x + v[j].y * v[j].y) + (v[j].z * v[j].z + v[j].w * v[j].w);
        const float rstd = 1.0f / sqrtf(wave_sum(ss) * (1.0f / DM) + 1e-6f);
        u32x2* o8 = (u32x2*)(H + (size_t)row * DM) + lane;
#pragma unroll
        for (int j = 0; j < 8; ++j) { const f32x4 gj = ((const f32x4*)g)[lane + 64 * j], sj = scp[lane + 64 * j], hj = sh[lane + 64 * j];
            const f32x4 y = v[j] * rstd * gj * (sj + 1.0f) + hj;
            u32x2 w; w.x = cvt_pk_bf16(y.x, y.y); w.y = cvt_pk_bf16(y.z, y.w); o8[64 * j] = w; }
    }
}

__device__ __forceinline__ void prep_phase(bf16_t* P, const float* na_gain, const float* wa_gain, const float* rope, int gthread, int nthreads) {
    const int sub = gthread & 15;
    for (int item = gthread >> 4; item < MT * 18; item += (nthreads >> 4)) {
        const int row = item / 18, hx = item - row * 18;
        int col; bool isq, iswa;
        if (hx < 4) { col = PC_NQ + 128 * hx; isq = true; iswa = false; }
        else if (hx < 8) { col = PC_NK + 128 * (hx - 4); isq = false; iswa = false; }
        else if (hx < 16) { col = PC_WQ + 128 * (hx - 8); isq = true; iswa = true; }
        else { col = PC_WK + 128 * (hx - 16); isq = false; iswa = true; }
        bf16_t* p = P + (size_t)row * INW + col + 8 * sub;
        const u32x4 raw = *(const u32x4*)p;
        float v[8];
        v[0] = __builtin_bit_cast(float, raw.x << 16); v[1] = __builtin_bit_cast(float, raw.x & 0xffff0000u);
        v[2] = __builtin_bit_cast(float, raw.y << 16); v[3] = __builtin_bit_cast(float, raw.y & 0xffff0000u);
        v[4] = __builtin_bit_cast(float, raw.z << 16); v[5] = __builtin_bit_cast(float, raw.z & 0xffff0000u);
        v[6] = __builtin_bit_cast(float, raw.w << 16); v[7] = __builtin_bit_cast(float, raw.w & 0xffff0000u);
        float ss = 0.f;
#pragma unroll
        for (int j = 0; j < 8; ++j) ss += v[j] * v[j];
        ss += __shfl_xor(ss, 1); ss += __shfl_xor(ss, 2); ss += __shfl_xor(ss, 4); ss += __shfl_xor(ss, 8);
        const float rstd = 1.0f / sqrtf(ss * (1.0f / 128.0f) + 1e-6f);
        const float* gn = (iswa ? wa_gain : na_gain) + (isq ? 0 : 128) + 8 * sub;
        const f32x4 g0 = *(const f32x4*)gn, g1 = *(const f32x4*)(gn + 4);
        v[0] *= rstd * g0.x; v[1] *= rstd * g0.y; v[2] *= rstd * g0.z; v[3] *= rstd * g0.w; v[4] *= rstd * g1.x; v[5] *= rstd * g1.y; v[6] *= rstd * g1.z; v[7] *= rstd * g1.w;
        if (iswa) {
            float pv[8];
#pragma unroll
            for (int j = 0; j < 8; ++j) pv[j] = __shfl_xor(v[j], 4);
            if (row < ML) {
                const int t = row & (SEQ - 1), pos = (sub >= 8) ? (t & 63) : (t >> 6);
                const int i0 = (8 * sub) & 31; const bool first = ((8 * sub) & 63) < 32;
                const float* tp = rope + ((size_t)pos * 32 + i0) * 2;
#pragma unroll
                for (int j = 0; j < 8; ++j) { const float c = tp[2 * j], s = tp[2 * j + 1]; v[j] = first ? (v[j] * c - pv[j] * s) : (v[j] * c + pv[j] * s); }
            }
        }
        if (isq) {
#pragma unroll
            for (int j = 0; j < 8; ++j) v[j] *= QSCALE;
        }
        u32x4 o; o.x = cvt_pk_bf16(v[0], v[1]); o.y = cvt_pk_bf16(v[2], v[3]); o.z = cvt_pk_bf16(v[4], v[5]); o.w = cvt_pk_bf16(v[6], v[7]);
        *(u32x4*)p = o;
    }
}

constexpr int POOL_A_OFF = 0, POOL_AS = 272, POOL_B_OFF = 256 * POOL_AS, POOL_LDS_END = POOL_B_OFF + 128 * POOL_AS;
static_assert(POOL_LDS_END <= LDSCTL_OFF, "pool LDS map");
template <int WIN> __device__ __forceinline__ void pool_a_tile(const bf16_t* __restrict__ up  , int t0, int L, int tid, LAS char* lds) {
#pragma unroll 2
    for (int it = 0; it < 8; ++it) { const int item = it * 512 + tid, row = item >> 4, cg = item & 15, t = t0 + row;
        float s[8], ctr[8];
#pragma unroll
        for (int j = 0; j < 8; ++j) s[j] = 0.f;
#pragma unroll
        for (int w = 0; w < WIN; ++w) { const int tt = t - WIN / 2 + w; const bool ok = (tt >= 0) && (tt < L); const int tc = tt < 0 ? 0 : (tt > L - 1 ? L - 1 : tt);
            const u32x4 raw = *(const u32x4*)(up + (size_t)tc * INW + 8 * cg); const float m = ok ? 1.f : 0.f;
            float f[8]; f[0] = __builtin_bit_cast(float, raw.x << 16); f[1] = __builtin_bit_cast(float, raw.x & 0xffff0000u); f[2] = __builtin_bit_cast(float, raw.y << 16); f[3] = __builtin_bit_cast(float, raw.y & 0xffff0000u);
            f[4] = __builtin_bit_cast(float, raw.z << 16); f[5] = __builtin_bit_cast(float, raw.z & 0xffff0000u); f[6] = __builtin_bit_cast(float, raw.w << 16); f[7] = __builtin_bit_cast(float, raw.w & 0xffff0000u);
#pragma unroll
            for (int j = 0; j < 8; ++j) { s[j] = fmaf(f[j], m, s[j]); if (w == WIN / 2) ctr[j] = f[j]; } }
        int lo = t - WIN / 2; lo = lo < 0 ? 0 : lo; int hi_ = t + WIN / 2 - 1; hi_ = hi_ > L - 1 ? L - 1 : hi_;
        const float inv = 1.0f / (float)(hi_ - lo + 1);
        u32x4 o; o.x = cvt_pk_bf16(s[0] * inv - ctr[0], s[1] * inv - ctr[1]); o.y = cvt_pk_bf16(s[2] * inv - ctr[2], s[3] * inv - ctr[3]);
        o.z = cvt_pk_bf16(s[4] * inv - ctr[4], s[5] * inv - ctr[5]); o.w = cvt_pk_bf16(s[6] * inv - ctr[6], s[7] * inv - ctr[7]);
        *(LAS u32x4*)(lds + POOL_A_OFF + row * POOL_AS + cg * 16) = o; }
}
__device__ __forceinline__ void pool_unit(const bf16_t* __restrict__ P, bf16_t* __restrict__ MIX, const float* __restrict__ pw, const float* __restrict__ pscale, int pm, int g, LAS char* lds) {
    int tid = threadIdx.x; asm volatile("" : "+v"(tid));
    const int wid = tid >> 6, lane = tid & 63, r32 = lane & 31, hi = lane >> 5;
    const int rowbase = pm * 256;
    int seq0, L; if (pm < ML / 256) { seq0 = (pm >> 5) * SEQ; L = SEQ; } else { seq0 = ML + (pm - ML / 256) * NCTX; L = NCTX; }
    __syncthreads();
    { const bf16_t* up = P + (size_t)seq0 * INW + PC_U + g * 128; const int t0 = rowbase - seq0;
      if (g == 0) pool_a_tile<2>(up, t0, L, tid, lds); else if (g == 1) pool_a_tile<4>(up, t0, L, tid, lds); else if (g == 2) pool_a_tile<8>(up, t0, L, tid, lds); else pool_a_tile<16>(up, t0, L, tid, lds);
      for (int idx = tid; idx < 128 * 128; idx += 512) { const int cc = idx >> 7, e = idx & 127;
          *(LAS unsigned short*)(lds + POOL_B_OFF + e * POOL_AS + cc * 2) = (unsigned short)f2bf(pw[(size_t)g * 16384 + idx]); } }
    __syncthreads();
    f32x16 acc[4] = {};
#pragma unroll
    for (int ks = 0; ks < 8; ++ks) { const bf16x8 a = *(const LAS bf16x8*)(lds + POOL_A_OFF + (32 * wid + r32) * POOL_AS + (16 * ks + 8 * hi) * 2);
#pragma unroll
        for (int nbk = 0; nbk < 4; ++nbk) { const bf16x8 bb = *(const LAS bf16x8*)(lds + POOL_B_OFF + (32 * nbk + r32) * POOL_AS + (16 * ks + 8 * hi) * 2);
            acc[nbk] = __builtin_amdgcn_mfma_f32_32x32x16_bf16(a, bb, acc[nbk], 0, 0, 0); } }
#pragma unroll
    for (int nbk = 0; nbk < 4; ++nbk) { const int e = 32 * nbk + r32; const float sc = pscale[g * 128 + e];
#pragma unroll
        for (int r = 0; r < 16; ++r) { const int row = rowbase + 32 * wid + att::crow(r, hi);
            MIX[(size_t)row * DM + 512 + g * 128 + e] = (bf16_t)f2bf(acc[nbk][r] * sc); } }
}

constexpr int NPH = 1 + 11 * DEPTH;
struct Args { const float* in[19]; float* out; unsigned char* ws; int ph_lo, ph_hi; };

template <int PHMASK> __global__ void __launch_bounds__(512, 2) fwd_kernel(Args args) {
    extern __shared__ __attribute__((aligned(16))) unsigned char lds_raw[];
    LAS unsigned char* lds = (LAS unsigned char*)lds_raw;
    const int G = gridDim.x, ngw = G * 8;
#define PHASE_IDS() int tid = threadIdx.x; asm volatile("" : "+v"(tid)); const int lane = tid & 63, wave = __builtin_amdgcn_readfirstlane(tid >> 6); \
    int bx = blockIdx.x; asm volatile("" : "+s"(bx)); const int vcu = (G % 8 == 0) ? (bx % 8) * (G / 8) + bx / 8 : bx; const int gw = vcu * 8 + wave; (void)lane; (void)gw; (void)vcu
    unsigned char* ws = args.ws;
    unsigned* ctl = (unsigned*)(ws + WS_CTL);
    float* MOD = (float*)(ws + WS_MOD);
    float* ROPE = (float*)(ws + WS_ROPE);
    float* XC = (float*)(ws + WS_XC);
    float* PART = (float*)(ws + WS_PART);
    float* DUML = (float*)(ws + WS_END); float* DUMC = (float*)(ws + WS_END + 256 * MiB);
    bf16_t* H = (bf16_t*)(ws + WS_H); bf16_t* HID = (bf16_t*)(ws + WS_HID); bf16_t* P = (bf16_t*)(ws + WS_P); bf16_t* MIX = (bf16_t*)(ws + WS_MIX);
    const float* x_in = args.in[0]; const float* c_in = args.in[1]; const float* ctx_in = args.in[2]; const float* cctx_in = args.in[3];
    const float* w_mod = args.in[4]; const float* b_mod = args.in[5]; const float* norm_w = args.in[6];
    const float* na_gain = args.in[13]; const float* na_rpb = args.in[14]; const float* pool_w = args.in[15]; const float* pool_scale = args.in[16];
    const float* wa_gain = args.in[17]; const float* wa_sink = args.in[18];
    float* xout = args.out;

    { const int t0 = threadIdx.x; if (t0 < 128) ((LAS unsigned*)(lds + LDSCTL_OFF))[t0] = 0u; }
    __syncthreads();
    const int lo = args.ph_lo, hi = args.ph_hi;
#if MK_SINGLE
    XcdBarrier bar = xcd_barrier_post(ctl + CW_BAR, (volatile LAS unsigned*)(lds + LDSCTL_OFF + 32));
#define GRID_BAR() xcd_barrier(bar)
#else
#define GRID_BAR() do { } while (0)
#endif
#define IN(k) (lo <= (k) && (k) < hi)
#define PHON(k) ((PHMASK >> (k)) & 1)
#define DUPREP(k) _Pragma("unroll") for (int rep = 0; rep <= ((DUPMASK >> (k)) & 1); ++rep)
#define ISDUMMY(k) (rep < ((DUPMASK >> (k)) & 1))
#define SEAM(k) do { if (IN((k) + 1)) GRID_BAR(); } while (0)

    if (PHON(0) && IN(0)) {
        PHASE_IDS();
        LAS float* scr = (LAS float*)(lds + wave * 16384);
        constexpr int I_WI = (DM / 64) * (2 * DFF / 64), I_WO = (DFF / 64) * (DM / 64), I_IN = (DM / 64) * (INW / 64), I_OUT = (DM / 64) * (DM / 64);
        constexpr int I_LAYER = 2 * I_WI + 2 * I_WO + I_IN + I_OUT;
        DUPREP(0)
        for (int it = gw; it < DEPTH * I_LAYER; it += ngw) {
            const int l = it / I_LAYER; int r = it - l * I_LAYER;
            unsigned char* wl = ws + WS_W + (size_t)l * W_LAYER;
            if (r < I_WI) { transpose_item(args.in[7] + (size_t)l * DM * 2 * DFF, DM, 2 * DFF, (bf16_t*)(wl + W_WI1), true, r, lane); continue; } r -= I_WI;
            if (r < I_WI) { transpose_item(args.in[9] + (size_t)l * DM * 2 * DFF, DM, 2 * DFF, (bf16_t*)(wl + W_WI2), true, r, lane); continue; } r -= I_WI;
            if (r < I_WO) { transpose_item(args.in[8] + (size_t)l * DFF * DM, DFF, DM, (bf16_t*)(wl + W_WO1), false, r, lane); continue; } r -= I_WO;
            if (r < I_WO) { transpose_item(args.in[10] + (size_t)l * DFF * DM, DFF, DM, (bf16_t*)(wl + W_WO2), false, r, lane); continue; } r -= I_WO;
            if (r < I_IN) { transpose_item(args.in[11] + (size_t)l * DM * INW, DM, INW, (bf16_t*)(wl + W_WIN), false, r, lane); continue; } r -= I_IN;
            transpose_item(args.in[12] + (size_t)l * DM * DM, DM, DM, (bf16_t*)(wl + W_WOUT), false, r, lane);
        }
        for (int it = gw; it < DEPTH * 72 * 16; it += ngw) {
            const int l = it / (72 * 16), r = it - l * (72 * 16), cc = r >> 4, ks = r & 15;
            LAS float* sv = scr;
            for (int i = lane; i < 5 * 128; i += 64) { const int s = i >> 7, k = ks * 128 + (i & 127); sv[i] = silu_f(s < 4 ? c_in[s * DM + k] : cctx_in[k]); }
            LDS_WAIT(); asm volatile("" ::: "memory");
            const float* wp = w_mod + ((size_t)l * DM + ks * 128) * MODW + cc * 256 + 4 * lane;
            f32x4 a0 = {0, 0, 0, 0}, a1 = a0, a2 = a0, a3 = a0, a4 = a0;
#pragma unroll 8
            for (int k = 0; k < 128; ++k) { const f32x4 w = *(const f32x4*)(wp + (size_t)k * MODW);
                a0 += w * sv[k]; a1 += w * sv[128 + k]; a2 += w * sv[256 + k]; a3 += w * sv[384 + k]; a4 += w * sv[512 + k]; }
            if (ks == 0) { const f32x4 bb = *(const f32x4*)(b_mod + (size_t)l * MODW + cc * 256 + 4 * lane); a0 += bb; a1 += bb; a2 += bb; a3 += bb; a4 += bb; }
            float* mo = MOD + (size_t)l * 5 * MODW + cc * 256 + 4 * lane;
#pragma unroll
            for (int j = 0; j < 4; ++j) { unsafeAtomicAdd(mo + j, a0[j]); unsafeAtomicAdd(mo + MODW + j, a1[j]); unsafeAtomicAdd(mo + 2 * MODW + j, a2[j]); unsafeAtomicAdd(mo + 3 * MODW + j, a3[j]); unsafeAtomicAdd(mo + 4 * MODW + j, a4[j]); }
            LDS_WAIT(); asm volatile("" ::: "memory");
        }
        for (int i = gw * 64 + lane; i < MC * DM / 4; i += ngw * 64) ((f32x4*)XC)[i] = ((const f32x4*)ctx_in)[i];
        { const int gt = gw * 64 + lane; if (gt < 128 * 32) { const int pos = gt >> 5, i = gt & 31; const float f = exp2f(-(float)i * 0.4152410118609203f); float c, s; sincos_small((float)pos * f, c, s); ROPE[2 * gt] = c; ROPE[2 * gt + 1] = s; } }
        SEAM(0);
    }

#pragma unroll LAYER_UNROLL
    for (int l = 0; l < DEPTH; ++l) {
        const int pb = 1 + 11 * l;
        unsigned char* wl = ws + WS_W + (size_t)l * W_LAYER;
        const float* modl = MOD + (size_t)l * 5 * MODW;
        const float* nw = norm_w + (size_t)l * 3 * DM;
        const float* xl_cur = (l == 0) ? x_in : xout;
        const float* xc_cur = XC;
        const bool lastl = (l == DEPTH - 1); const int MPOST = lastl ? ML : MT;

        if (PHON(1) && IN(pb + 0)) { DUPREP(1) { PHASE_IDS(); norm_phase(xl_cur, xc_cur, XC, (l > 0 && rep == 0) ? PART : nullptr, nw, modl, 0, 1, H, MT, gw, ngw, lane); } SEAM(pb + 0); }
        if (PHON(2) && IN(pb + 1)) {
            DUPREP(2) {
            PHASE_IDS();
            pg8::Gemm g{H, (const bf16_t*)(wl + W_WI1), MT, 2 * DFF, DM, DM}; pg8::StaticOrder S; S.init(MT, 2 * DFF, G, bx);
            pg8::EpiSwiglu E{HID};
            pg8::gemm_phase<pg8::EpiSwiglu, pg8::StaticOrder, true, true>(lds, g, S, E);
            }
            SEAM(pb + 1);
        }
        if (PHON(3) && IN(pb + 2)) {
            DUPREP(3) {
            PHASE_IDS();
            pg8::Gemm g{HID, (const bf16_t*)(wl + W_WO1), ML, DM, DFF, DFF}; pg8::StaticOrder S; S.init(ML, DM, G, bx, RESID_WGM);
            pg8::EpiResid E{xl_cur, XC, ISDUMMY(3) ? DUML : xout, XC, modl + 2 * DM, 0.5f};
            pg8::gemm_phase<pg8::EpiResid, pg8::StaticOrder, true, true>(lds, g, S, E);
            if (!ISDUMMY(3)) {
                pg8::Gemm gc{HID + (size_t)ML * DFF, (const bf16_t*)(wl + W_WO1), MC, DM, DFF / 4, DFF}; pg8::CtxSplitOrder SC{bx, (unsigned)(DFF / 4) * 2u};
                pg8::EpiPartial EC{PART, modl + 4 * MODW + 2 * DM, 0.5f, (unsigned)(DFF / 4) * 2u};
                pg8::gemm_phase<pg8::EpiPartial, pg8::CtxSplitOrder, true, true>(lds, gc, SC, EC);
            }
            }
            SEAM(pb + 2);
        }
        if (PHON(4) && IN(pb + 3)) { DUPREP(4) { PHASE_IDS(); norm_phase(xout, XC, XC, rep == 0 ? PART : nullptr, nw + DM, modl, 3, 4, H, MT, gw, ngw, lane); } SEAM(pb + 3); }
        if (PHON(5) && IN(pb + 4)) {
            DUPREP(5) {
            PHASE_IDS();
            pg8::Gemm g{H, (const bf16_t*)(wl + W_WIN), MT, INW, DM, DM}; pg8::StaticOrder S; S.init(MT, INW, G, bx);
            pg8::EpiBf16 E{P, INW};
            pg8::gemm_phase<pg8::EpiBf16, pg8::StaticOrder, true, true>(lds, g, S, E);
            }
            SEAM(pb + 4);
        }
        if (PHON(6) && IN(pb + 5)) { PHASE_IDS(); prep_phase(P, na_gain + (size_t)l * 256, wa_gain + (size_t)l * 256, ROPE, gw * 64 + lane, ngw * 64); SEAM(pb + 5); }
        if (PHON(7) && IN(pb + 6)) {
            DUPREP(7) {
            PHASE_IDS();
            const float* sinkp = wa_sink + l * 8; const float* rpbp = na_rpb + (size_t)l * 4 * 15 * 31;
            constexpr int U_WA = 1024, U_NA = 512;
            const int U_CN = lastl ? 0 : 16, U_CW = lastl ? 0 : 32, U_ATT = U_WA + U_NA + U_CN + U_CW, U_POOL = (MPOST / 256) * 4;
            for (int idx = vcu; idx < U_ATT + U_POOL; idx += G) {
                if (idx < U_WA) { att::attn_unit(P, MIX, sinkp, rpbp, 0, idx >> 8, (idx >> 2) & 63, idx & 3, (LAS char*)lds); }
                else if (idx < U_WA + U_NA) { const int r = idx - U_WA; att::attn_unit(P, MIX, sinkp, rpbp, 1, r >> 7, (r >> 2) & 31, r & 3, (LAS char*)lds); }
                else if (idx < U_WA + U_NA + U_CN) { const int r = idx - U_WA - U_NA; att::attn_unit(P, MIX, sinkp, rpbp, 2, r >> 2, r & 3, 0, (LAS char*)lds); }
                else if (idx < U_ATT) { const int r = idx - U_WA - U_NA - U_CN; att::attn_unit(P, MIX, sinkp, rpbp, 3, r >> 3, r & 7, 0, (LAS char*)lds); }
                else { const int r = idx - U_ATT; __syncthreads(); pool_unit(P, MIX, pool_w + (size_t)l * 4 * 16384, pool_scale + (size_t)l * 512, r >> 2, r & 3, (LAS char*)lds); }
            }
            }
            SEAM(pb + 6);
        }
        if (PHON(8) && IN(pb + 7)) {
            DUPREP(8) {
            PHASE_IDS();
            pg8::Gemm g{MIX, (const bf16_t*)(wl + W_WOUT), ML, DM, DM, DM}; pg8::StaticOrder S; S.init(ML, DM, G, bx, RESID_WGM);
            pg8::EpiResid E{xout, XC, ISDUMMY(8) ? DUML : xout, XC, modl + 5 * DM, 1.0f};
            pg8::gemm_phase<pg8::EpiResid, pg8::StaticOrder, true, true>(lds, g, S, E);
            if (!lastl && !ISDUMMY(8)) {
                pg8::Gemm gc{MIX + (size_t)ML * DM, (const bf16_t*)(wl + W_WOUT), MC, DM, DM / 4, DM}; pg8::CtxSplitOrder SC{bx, (unsigned)(DM / 4) * 2u};
                pg8::EpiPartial EC{PART, modl + 4 * MODW + 5 * DM, 1.0f, (unsigned)(DM / 4) * 2u};
                pg8::gemm_phase<pg8::EpiPartial, pg8::CtxSplitOrder, true, true>(lds, gc, SC, EC);
            }
            }
            SEAM(pb + 7);
        }
        if (PHON(9) && IN(pb + 8)) { DUPREP(9) { PHASE_IDS(); norm_phase(xout, XC, XC, rep == 0 ? PART : nullptr, nw + 2 * DM, modl, 6, 7, H, MPOST, gw, ngw, lane); } SEAM(pb + 8); }
        if (PHON(10) && IN(pb + 9)) {
            DUPREP(10) {
            PHASE_IDS();
            pg8::Gemm g{H, (const bf16_t*)(wl + W_WI2), MPOST, 2 * DFF, DM, DM}; pg8::StaticOrder S; S.init(MPOST, 2 * DFF, G, bx);
            pg8::EpiSwiglu E{HID};
            pg8::gemm_phase<pg8::EpiSwiglu, pg8::StaticOrder, true, true>(lds, g, S, E);
            }
            SEAM(pb + 9);
        }
        if (PHON(11) && IN(pb + 10)) {
            DUPREP(11) {
            PHASE_IDS();
            pg8::Gemm g{HID, (const bf16_t*)(wl + W_WO2), ML, DM, DFF, DFF}; pg8::StaticOrder S; S.init(ML, DM, G, bx, RESID_WGM);
            pg8::EpiResid E{xout, XC, ISDUMMY(11) ? DUML : xout, XC, modl + 8 * DM, 0.5f};
            pg8::gemm_phase<pg8::EpiResid, pg8::StaticOrder, true, true>(lds, g, S, E);
            if (!lastl && !ISDUMMY(11)) {
                pg8::Gemm gc{HID + (size_t)ML * DFF, (const bf16_t*)(wl + W_WO2), MC, DM, DFF / 4, DFF}; pg8::CtxSplitOrder SC{bx, (unsigned)(DFF / 4) * 2u};
                pg8::EpiPartial EC{PART, modl + 4 * MODW + 8 * DM, 0.5f, (unsigned)(DFF / 4) * 2u};
                pg8::gemm_phase<pg8::EpiPartial, pg8::CtxSplitOrder, true, true>(lds, gc, SC, EC);
            }
            }
            if (l + 1 < DEPTH) SEAM(pb + 10);
        }
    }
#undef IN
#undef SEAM
#undef GRID_BAR
}

template <int PHMASK> static bool prep_kernel(int& per_cu) {
    if (hipFuncSetAttribute((const void*)fwd_kernel<PHMASK>, hipFuncAttributeMaxDynamicSharedMemorySize, LDS_BYTES) != hipSuccess) { fprintf(stderr, "kernel_launch: hipFuncSetAttribute failed (mask %x)\n", PHMASK); return false; }
    if (hipOccupancyMaxActiveBlocksPerMultiprocessor(&per_cu, (const void*)fwd_kernel<PHMASK>, 512, LDS_BYTES) != hipSuccess || per_cu < 1) fprintf(stderr, "kernel_launch: occupancy query reports %d (mask %x)\n", per_cu, PHMASK);
    (void)hipGetLastError();
    return true;
}
template <int PHMASK> static void launch_k(int grid, const Args& a, hipStream_t stream) { hipLaunchKernelGGL(fwd_kernel<PHMASK>, dim3(grid), dim3(512), LDS_BYTES, stream, a); }
extern "C" void kernel_launch(void* const* d_in, const int* in_sizes, int n_in, void* d_out, int out_size, void* d_ws, size_t ws_size, hipStream_t stream) {
    static int grid = 0;
    if (grid == 0) {
        if (n_in != 19 || in_sizes[0] != ML * DM || out_size != ML * DM || ws_size < WS_END + (DUPMASK ? 264 * MiB : 0)) {
            fprintf(stderr, "kernel_launch: shape mismatch: n_in %d in0 %d out %d ws %zu (need %zu)\n", n_in, n_in > 0 ? in_sizes[0] : -1, out_size, ws_size, (size_t)WS_END); grid = -1; return; }
        int dev = 0, cus = 0, per_cu = 0; bool ok = true;
        if (hipGetDevice(&dev) != hipSuccess || hipDeviceGetAttribute(&cus, hipDeviceAttributeMultiprocessorCount, dev) != hipSuccess) { grid = -1; return; }
#if MK_SINGLE
        ok = prep_kernel<0xFFF>(per_cu);
#else
        ok = prep_kernel<1>(per_cu) && prep_kernel<2>(per_cu) && prep_kernel<4>(per_cu) && prep_kernel<8>(per_cu) && prep_kernel<16>(per_cu) && prep_kernel<32>(per_cu) && prep_kernel<64>(per_cu)
          && prep_kernel<128>(per_cu) && prep_kernel<256>(per_cu) && prep_kernel<512>(per_cu) && prep_kernel<1024>(per_cu) && prep_kernel<2048>(per_cu);
#endif
        if (!ok) { grid = -1; return; }
        grid = cus;
    }
    if (grid < 0) return;
    if (hipMemsetAsync((char*)d_ws + WS_CTL, 0, CTL_ZERO_BYTES, stream) != hipSuccess) { fprintf(stderr, "kernel_launch: memset failed\n"); return; }
    Args a{};
    for (int i = 0; i < 19; ++i) a.in[i] = (const float*)d_in[i];
    a.out = (float*)d_out; a.ws = (unsigned char*)d_ws;
#if MK_SINGLE
    a.ph_lo = 0; a.ph_hi = NPH;
    launch_k<0xFFF>(grid, a, stream);
#else
    for (int ph = 0; ph < NPH; ++ph) { a.ph_lo = ph; a.ph_hi = ph + 1;
        const int bit = (ph == 0) ? 0 : 1 + (ph - 1) % 11;
        switch (bit) { case 0: launch_k<1>(grid, a, stream); break; case 1: launch_k<2>(grid, a, stream); break; case 2: launch_k<4>(grid, a, stream); break; case 3: launch_k<8>(grid, a, stream); break;
            case 4: launch_k<16>(grid, a, stream); break; case 5: launch_k<32>(grid, a, stream); break; case 6: launch_k<64>(grid, a, stream); break; case 7: launch_k<128>(grid, a, stream); break;
            case 8: launch_k<256>(grid, a, stream); break; case 9: launch_k<512>(grid, a, stream); break; case 10: launch_k<1024>(grid, a, stream); break; default: launch_k<2048>(grid, a, stream); break; } }
#endif
    const hipError_t le = hipPeekAtLastError();
    if (le != hipSuccess) fprintf(stderr, "kernel_launch: launch failed: %s\n", hipGetErrorName(le));
}
```

```cpp
#include <hip/hip_runtime.h>
#include <cstdio>
#include <cstdint>

#ifndef DBG_MASK
#define DBG_MASK 0xFFF
#endif
#ifndef DUPMASK
#define DUPMASK 0
#endif
#ifndef ATT_PIPE2
#define ATT_PIPE2 1
#endif
#ifndef RESID_WGM
#define RESID_WGM 4
#endif
#ifndef LAYER_UNROLL
#define LAYER_UNROLL 2
#endif
#ifndef MK_SINGLE
#define MK_SINGLE 1
#endif

#define GAS __attribute__((address_space(1)))
#define LAS __attribute__((address_space(3)))
typedef unsigned short bf16_t;
typedef short bf16x8 __attribute__((ext_vector_type(8)));
typedef short s16x4 __attribute__((ext_vector_type(4)));
typedef float f32x4 __attribute__((ext_vector_type(4)));
typedef float f32x16 __attribute__((ext_vector_type(16)));
typedef unsigned u32x4 __attribute__((ext_vector_type(4)));
typedef unsigned u32x2 __attribute__((ext_vector_type(2)));

constexpr int DM = 2048, NBATCH = 4, SEQ = 8192, NCTX = 256, DFF = 5632, INW = 3584, DEPTH = 2, MODW = 9 * DM;
constexpr int ML = NBATCH * SEQ, MC = NBATCH * NCTX, MT = ML + MC;
constexpr float LOG2E = 1.4426950408889634f;
constexpr float QSCALE = 0.088388347648318440f * LOG2E;
constexpr int PC_NQ = 0, PC_NK = 512, PC_NV = 1024, PC_U = 1536, PC_WQ = 2048, PC_WK = 3072, PC_WV = 3328;

constexpr size_t MiB = 1u << 20;
constexpr size_t WS_CTL = 0, CTL_ZERO_BYTES = 1 * MiB;
constexpr size_t WS_MOD = 256 * 1024;
constexpr size_t WS_ROPE = 1 * MiB;
constexpr size_t WS_W = 2 * MiB;
constexpr size_t W_WI1 = 0, W_WO1 = 44 * MiB, W_WIN = 66 * MiB, W_WOUT = 80 * MiB, W_WI2 = 88 * MiB, W_WO2 = 132 * MiB, W_LAYER = 154 * MiB;
constexpr size_t WS_XC = WS_W + 2 * W_LAYER;
constexpr size_t WS_H = WS_XC + 8 * MiB;
constexpr size_t WS_HID = WS_H + 132 * MiB;
constexpr size_t WS_P = WS_HID;
constexpr size_t WS_MIX = WS_HID + 231 * MiB;
constexpr size_t WS_PART = WS_HID + 363 * MiB;
constexpr size_t WS_END = WS_PART + 32 * MiB;
static_assert((size_t)MT * DFF * 2 == 363 * MiB && (size_t)MT * INW * 2 == 231 * MiB && (size_t)MT * DM * 2 == 132 * MiB, "ws map");
static_assert(WS_MOD + (size_t)DEPTH * 5 * MODW * 4 <= CTL_ZERO_BYTES, "MOD inside the zeroed region");
constexpr int CW_BAR = 4096;

constexpr int LDS_BYTES = 147456;
constexpr int LDSCTL_OFF = LDS_BYTES - 512;

__device__ __forceinline__ unsigned f2bf(float f) { unsigned u = __builtin_bit_cast(unsigned, f); return (u + 0x7fffu + ((u >> 16) & 1u)) >> 16; }
__device__ __forceinline__ unsigned cvt_pk_bf16(float lo, float hi) { unsigned r; asm volatile("v_cvt_pk_bf16_f32 %0, %1, %2" : "=v"(r) : "v"(lo), "v"(hi)); return r; }
__device__ __forceinline__ float bf2f(unsigned short b) { return __builtin_bit_cast(float, (unsigned)b << 16); }
__device__ __forceinline__ float wave_sum(float v) {
#pragma unroll
    for (int o = 1; o < 64; o <<= 1) v += __shfl_xor(v, o);
    return v;
}
#define LDS_WAIT() asm volatile("s_waitcnt lgkmcnt(0)" ::: "memory")
#define VM_WAIT() asm volatile("s_waitcnt vmcnt(0)" ::: "memory")

namespace pg8 {
constexpr int BM = 256, BK = 64, HALF = 128, HTB = HALF * BK * 2, STAGE_BYTES = 8 * HTB, NXCD = 8, WGM = 8;
__host__ __device__ __forceinline__ int lds_byte(int r, int c) { const int st = (r >> 4) * 2 + (c >> 5), rr = r & 15, cc = c & 31, ob = rr * 64 + cc * 2; return st * 1024 + (ob ^ (((ob >> 9) & 1) << 5)); }
__host__ __device__ __forceinline__ void stage_rc(int b, int& R, int& C) { const int st = b / 1024, sb = b % 1024, swz = sb ^ (((sb >> 9) & 1) << 5); R = (st >> 1) * 16 + swz / 64; C = (st & 1) * 32 + (swz % 64) / 2; }
__host__ __device__ __forceinline__ int perm32(int rho) { const int n = rho >> 4, i = rho & 15; return 8 * (i >> 2) + 4 * n + (i & 3); }
struct Unit { int pm, pn; unsigned koff; };
struct Gemm { const bf16_t* A; const bf16_t* Bt; int M, N, K, ld; };
struct StaticOrder {
    int nM, nN, nwg, G, c, wgm;
    __host__ __device__ void init(int M, int N, int G_, int c_, int wgm_ = WGM) { nM = M / BM; nN = N / BM; nwg = nM * nN; G = G_; c = c_; wgm = wgm_; }
    __host__ __device__ bool next(int i, Unit& u) const {
        const long L = (long)i * G + c; if (L >= nwg) return false;
        int wgid = (int)L; { const int q = nwg / NXCD, r = nwg % NXCD, xcd = wgid % NXCD, off = wgid / NXCD; wgid = (xcd < r ? xcd * (q + 1) : r * (q + 1) + (xcd - r) * q) + off; }
        const int nig = wgm * nN, gid = wgid / nig, fm = gid * wgm, gsz = (nM - fm) < wgm ? (nM - fm) : wgm;
        u.pm = fm + ((wgid % nig) % gsz); u.pn = (wgid % nig) / gsz; u.koff = 0u; return true;
    }
    __device__ __forceinline__ void a_ready(const Unit&) const {}
    __device__ __forceinline__ void done(const Unit&) const {}
};

struct EpiBf16 {
    static constexpr bool PERM = true, AFTER_DRAIN = false;
    bf16_t* O; int ldc;
    __device__ __forceinline__ void operator()(const f32x4 (&acc)[2][2][4][2], const Unit& u, int wr, int wc, int fr, int fq) const {
        const int row0 = u.pm * BM + wr * 64 + fr, col0 = u.pn * BM + wc * 32 + 8 * fq;
#pragma unroll
        for (int ai = 0; ai < 2; ++ai)
#pragma unroll
            for (int m = 0; m < 4; ++m) { bf16_t* rowp = O + (size_t)(row0 + ai * HALF + m * 16) * ldc + col0;
#pragma unroll
                for (int bj = 0; bj < 2; ++bj) { const f32x4 v0 = acc[ai][bj][m][0], v1 = acc[ai][bj][m][1];
                    u32x4 w; w.x = cvt_pk_bf16(v0[0], v0[1]); w.y = cvt_pk_bf16(v0[2], v0[3]); w.z = cvt_pk_bf16(v1[0], v1[1]); w.w = cvt_pk_bf16(v1[2], v1[3]);
                    *(u32x4*)(rowp + bj * HALF) = w; } }
    }
};
__device__ __forceinline__ float silu_mul(float a, float b) { return a * b * __builtin_amdgcn_rcpf(1.0f + __builtin_amdgcn_exp2f(-a * LOG2E)); }
struct EpiSwiglu {
    static constexpr bool PERM = true, AFTER_DRAIN = false;
    bf16_t* O;
    __device__ __forceinline__ void operator()(const f32x4 (&acc)[2][2][4][2], const Unit& u, int wr, int wc, int fr, int fq) const {
        const int row0 = u.pm * BM + wr * 64 + fr, col0 = u.pn * HALF + wc * 32 + 8 * fq;
#pragma unroll
        for (int ai = 0; ai < 2; ++ai)
#pragma unroll
            for (int m = 0; m < 4; ++m) { bf16_t* rowp = O + (size_t)(row0 + ai * HALF + m * 16) * DFF + col0;
                const f32x4 a0 = acc[ai][0][m][0], a1 = acc[ai][0][m][1], b0 = acc[ai][1][m][0], b1 = acc[ai][1][m][1];
                u32x4 w; w.x = cvt_pk_bf16(silu_mul(a0[0], b0[0]), silu_mul(a0[1], b0[1])); w.y = cvt_pk_bf16(silu_mul(a0[2], b0[2]), silu_mul(a0[3], b0[3]));
                w.z = cvt_pk_bf16(silu_mul(a1[0], b1[0]), silu_mul(a1[1], b1[1])); w.w = cvt_pk_bf16(silu_mul(a1[2], b1[2]), silu_mul(a1[3], b1[3]));
                *(u32x4*)rowp = w; }
    }
};
struct EpiResid {
    static constexpr bool PERM = false, AFTER_DRAIN = false;
    const float* xin_l; const float* xin_c; float* xout_l; float* xout_c; const float* gate; float gs;
    __device__ __forceinline__ void operator()(const f32x4 (&acc)[2][2][4][2], const Unit& u, int wr, int wc, int fr, int fq) const {
        const bool lat = u.pm < (ML / BM); const int s = lat ? (u.pm >> 5) : 4;
        const float* xi = lat ? xin_l + (size_t)u.pm * BM * DM : xin_c + (size_t)(u.pm - ML / BM) * BM * DM;
        float* xo = lat ? xout_l + (size_t)u.pm * BM * DM : xout_c + (size_t)(u.pm - ML / BM) * BM * DM;
        const int r0 = wr * 64 + fr, col0 = u.pn * BM + wc * 32 + 4 * fq;
        const float* gp = gate + (size_t)s * MODW + col0;
#pragma unroll
        for (int bj = 0; bj < 2; ++bj)
#pragma unroll
            for (int n = 0; n < 2; ++n) { const f32x4 gv = *(const f32x4*)(gp + bj * HALF + n * 16) * gs;
#pragma unroll
                for (int ai = 0; ai < 2; ++ai)
#pragma unroll
                    for (int m = 0; m < 4; ++m) { const size_t off = (size_t)(r0 + ai * HALF + m * 16) * DM + col0 + bj * HALF + n * 16;
                        const f32x4 xv = *(const f32x4*)(xi + off); *(f32x4*)(xo + off) = xv + gv * acc[ai][bj][m][n]; } }
    }
};

struct CtxSplitOrder {
    int c; unsigned kq_bytes;
    __device__ bool next(int i, Unit& u) const { if (i != 0 || c >= 128) return false; const int t = c >> 2; u.pm = t & 3; u.pn = t >> 2; u.koff = (unsigned)(c & 3) * kq_bytes; return true; }
    __device__ __forceinline__ void a_ready(const Unit&) const {}
    __device__ __forceinline__ void done(const Unit&) const {}
};
struct EpiPartial {
    static constexpr bool PERM = false, AFTER_DRAIN = false;
    float* part; const float* gate; float gs; unsigned kqb;
    __device__ __forceinline__ void operator()(const f32x4 (&acc)[2][2][4][2], const Unit& u, int wr, int wc, int fr, int fq) const {
        float* xo = part + (size_t)(u.koff / kqb) * MC * DM + (size_t)u.pm * BM * DM;
        const int r0 = wr * 64 + fr, col0 = u.pn * BM + wc * 32 + 4 * fq;
        const float* gp = gate + col0;
#pragma unroll
        for (int bj = 0; bj < 2; ++bj)
#pragma unroll
            for (int n = 0; n < 2; ++n) { const f32x4 gv = *(const f32x4*)(gp + bj * HALF + n * 16) * gs;
#pragma unroll
                for (int ai = 0; ai < 2; ++ai)
#pragma unroll
                    for (int m = 0; m < 4; ++m) *(f32x4*)(xo + (size_t)(r0 + ai * HALF + m * 16) * DM + col0 + bj * HALF + n * 16) = gv * acc[ai][bj][m][n]; }
    }
};

template <class Epi, class Sched, bool ALIGN_EPI = false, bool SP2 = false>
__device__ __forceinline__ void gemm_phase(LAS unsigned char* lds, const Gemm g, const Sched& S, const Epi& E) {
    int tid = threadIdx.x; asm volatile("" : "+v"(tid));
    const int wid = __builtin_amdgcn_readfirstlane(tid >> 6), lane = tid & 63, wr = wid >> 2, wc = wid & 3, fr = lane & 15, fq = lane >> 4;
    const int K = g.ld, nt = g.K / BK;
    unsigned voffA[2], voffB[2];
#pragma unroll
    for (int i = 0; i < 2; ++i) { int R, C; stage_rc(tid * 16 + i * 8192, R, C); const int Rb = Epi::PERM ? ((R & ~31) + perm32(R & 31)) : R;
        voffA[i] = (unsigned)(R * K + C) * 2u; voffB[i] = (unsigned)(Rb * K + C) * 2u; }
    const size_t kstep = (size_t)(BK * 2);
    const size_t hstep = (size_t)HALF * K * 2;
    const size_t tstep = 2 * hstep;
    const unsigned ldsw = (unsigned)wid * 1024u;
    const int aoff = lds_byte(wr * 64 + fr, fq * 8), boff = lds_byte(wc * 32 + fr, fq * 8);
#define PG8_SA(b, h) (((b) * 2 + (h)) * HTB)
#define PG8_SB(b, h) ((4 + (b) * 2 + (h)) * HTB)
#define PG8_STAGE(bufoff, gbase, voff) do { _Pragma("unroll") for (int _i = 0; _i < 2; ++_i) \
        __builtin_amdgcn_global_load_lds((const unsigned*)((const char*)(gbase) + (voff)[_i]), (LAS unsigned*)(lds + (bufoff) + ldsw + _i * 8192), 16, 0, 0); } while (0)
#define PG8_LDA(dst, b, h) do { _Pragma("unroll") for (int m = 0; m < 4; ++m) _Pragma("unroll") for (int k = 0; k < 2; ++k) dst[m][k] = *(const LAS bf16x8*)(lds + PG8_SA(b, h) + aoff + m * 2048 + k * 1024); } while (0)
#define PG8_LDB(dst, b, h) do { _Pragma("unroll") for (int n = 0; n < 2; ++n) _Pragma("unroll") for (int k = 0; k < 2; ++k) dst[n][k] = *(const LAS bf16x8*)(lds + PG8_SB(b, h) + boff + n * 2048 + k * 1024); } while (0)
#define PG8_MMA(ai, bj, At, Bt) do { __builtin_amdgcn_s_setprio(1); _Pragma("unroll") for (int m = 0; m < 4; ++m) _Pragma("unroll") for (int n = 0; n < 2; ++n) _Pragma("unroll") for (int k = 0; k < 2; ++k) \
        acc[ai][bj][m][n] = __builtin_amdgcn_mfma_f32_16x16x32_bf16(Bt[n][k], At[m][k], acc[ai][bj][m][n], 0, 0, 0); __builtin_amdgcn_s_setprio(0); } while (0)
#define PG8_WAIT_V(n) asm volatile("s_waitcnt vmcnt(" #n ")" ::: "memory")
#define PG8_WAIT_L(n) asm volatile("s_waitcnt lgkmcnt(" #n ")" ::: "memory")
#define PG8_BAR __builtin_amdgcn_s_barrier()
#define PG8_SCHED __builtin_amdgcn_sched_barrier(0)
    Unit cur, nxt; int ui = 0;
    if (!S.next(0, cur)) return;
    f32x4 acc[2][2][4][2];
#pragma unroll
    for (int a = 0; a < 2; ++a)
#pragma unroll
        for (int b = 0; b < 2; ++b)
#pragma unroll
            for (int m = 0; m < 4; ++m)
#pragma unroll
                for (int n = 0; n < 2; ++n) acc[a][b][m][n] = (f32x4){0.f, 0.f, 0.f, 0.f};
    bf16x8 At[4][2], B0[2][2], B1[2][2];
    const char* cA = (const char*)g.A + (size_t)cur.pm * tstep + cur.koff; const char* cB = (const char*)g.Bt + (size_t)cur.pn * tstep + cur.koff;
    S.a_ready(cur);
    if constexpr (SP2) {
        PG8_STAGE(PG8_SB(0, 0), cB, voffB); PG8_STAGE(PG8_SB(0, 1), cB + hstep, voffB); PG8_STAGE(PG8_SA(0, 0), cA, voffA); PG8_STAGE(PG8_SA(0, 1), cA + hstep, voffA);
        if (wr == 1) PG8_BAR;
        PG8_WAIT_V(2); PG8_BAR;
        PG8_STAGE(PG8_SB(1, 0), cB + kstep, voffB); PG8_STAGE(PG8_SA(1, 0), cA + kstep, voffA); PG8_STAGE(PG8_SB(1, 1), cB + hstep + kstep, voffB);
        PG8_WAIT_V(6); PG8_BAR;
    } else {
        PG8_STAGE(PG8_SB(0, 0), cB, voffB); PG8_STAGE(PG8_SA(0, 0), cA, voffA); PG8_STAGE(PG8_SB(0, 1), cB + hstep, voffB); PG8_STAGE(PG8_SA(0, 1), cA + hstep, voffA);
        if (wr == 1) PG8_BAR;
        PG8_WAIT_V(4); PG8_BAR;
        PG8_STAGE(PG8_SB(1, 0), cB + kstep, voffB); PG8_STAGE(PG8_SA(1, 0), cA + kstep, voffA); PG8_STAGE(PG8_SB(1, 1), cB + hstep + kstep, voffB);
        PG8_WAIT_V(6); PG8_BAR;
    }
    for (;;) {
        const bool has_next = S.next(ui + 1, nxt);
        const char* nA = has_next ? (const char*)g.A + (size_t)nxt.pm * tstep + nxt.koff : cA; const char* nB = has_next ? (const char*)g.Bt + (size_t)nxt.pn * tstep + nxt.koff : cB;
        for (int t = 0; t < nt; t += 2) {
            const bool last = (t == nt - 2);
            const char* a1 = cA + (size_t)(t + 1) * kstep;
            const char* a2 = last ? nA : cA + (size_t)(t + 2) * kstep; const char* b2 = last ? nB : cB + (size_t)(t + 2) * kstep;
            const char* a3 = a2 + kstep; const char* b3 = b2 + kstep;
            if (last && has_next) S.a_ready(nxt);
            if constexpr (SP2) {
            PG8_LDB(B0, 0, 0); PG8_LDB(B1, 0, 1); PG8_SCHED; PG8_LDA(At, 0, 0); PG8_STAGE(PG8_SA(1, 1), a1 + hstep, voffA);
            PG8_WAIT_V(8); PG8_WAIT_L(0); PG8_BAR; PG8_MMA(0, 0, At, B0); PG8_MMA(0, 1, At, B1); PG8_BAR; PG8_SCHED;
            PG8_LDA(At, 0, 1); PG8_STAGE(PG8_SB(0, 0), b2, voffB); PG8_STAGE(PG8_SB(0, 1), b2 + hstep, voffB); PG8_STAGE(PG8_SA(0, 0), a2, voffA);
            PG8_WAIT_V(8); PG8_WAIT_L(0); PG8_BAR; PG8_MMA(1, 0, At, B0); PG8_MMA(1, 1, At, B1); PG8_BAR; PG8_SCHED;
            PG8_LDB(B0, 1, 0); PG8_LDB(B1, 1, 1); PG8_SCHED; PG8_LDA(At, 1, 0); PG8_STAGE(PG8_SA(0, 1), a2 + hstep, voffA);
            PG8_WAIT_V(8); PG8_WAIT_L(0); PG8_BAR; PG8_MMA(0, 0, At, B0); PG8_MMA(0, 1, At, B1); PG8_BAR; PG8_SCHED;
            PG8_LDA(At, 1, 1); PG8_STAGE(PG8_SB(1, 0), b3, voffB); PG8_STAGE(PG8_SB(1, 1), b3 + hstep, voffB); PG8_STAGE(PG8_SA(1, 0), a3, voffA);
            PG8_WAIT_V(8); PG8_WAIT_L(0); PG8_BAR; PG8_MMA(1, 0, At, B0); PG8_MMA(1, 1, At, B1); PG8_BAR; PG8_SCHED;
            } else {
            PG8_LDB(B0, 0, 0); PG8_SCHED; PG8_LDA(At, 0, 0); PG8_STAGE(PG8_SA(1, 1), a1 + hstep, voffA);
            PG8_WAIT_L(8); PG8_BAR; PG8_WAIT_L(0); PG8_MMA(0, 0, At, B0); PG8_BAR; PG8_SCHED;
            PG8_LDB(B1, 0, 1); PG8_STAGE(PG8_SB(0, 0), b2, voffB);
            PG8_BAR; PG8_WAIT_L(0); PG8_MMA(0, 1, At, B1); PG8_BAR;
            PG8_LDA(At, 0, 1); PG8_STAGE(PG8_SA(0, 0), a2, voffA);
            PG8_BAR; PG8_WAIT_L(0); PG8_MMA(1, 0, At, B0); PG8_BAR; PG8_SCHED;
            PG8_STAGE(PG8_SB(0, 1), b2 + hstep, voffB);
            PG8_WAIT_V(6); PG8_BAR; PG8_MMA(1, 1, At, B1); PG8_BAR;
            PG8_LDB(B0, 1, 0); PG8_SCHED; PG8_LDA(At, 1, 0); PG8_STAGE(PG8_SA(0, 1), a2 + hstep, voffA);
            PG8_WAIT_L(8); PG8_BAR; PG8_WAIT_L(0); PG8_MMA(0, 0, At, B0); PG8_BAR; PG8_SCHED;
            PG8_LDB(B1, 1, 1); PG8_STAGE(PG8_SB(1, 0), b3, voffB);
            PG8_BAR; PG8_WAIT_L(0); PG8_MMA(0, 1, At, B1); PG8_BAR;
            PG8_LDA(At, 1, 1); PG8_STAGE(PG8_SA(1, 0), a3, voffA);
            PG8_BAR; PG8_WAIT_L(0); PG8_MMA(1, 0, At, B0); PG8_BAR; PG8_SCHED;
            PG8_STAGE(PG8_SB(1, 1), b3 + hstep, voffB);
            PG8_WAIT_V(6); PG8_BAR; PG8_MMA(1, 1, At, B1); PG8_BAR;
            }
        }
        if constexpr (ALIGN_EPI) { if (wr == 0) PG8_BAR; }
        if constexpr (!Epi::AFTER_DRAIN) { E(acc, cur, wr, wc, fr, fq); S.done(cur); }
        if (!has_next) break;
#pragma unroll
        for (int a = 0; a < 2; ++a)
#pragma unroll
            for (int b = 0; b < 2; ++b)
#pragma unroll
                for (int m = 0; m < 4; ++m)
#pragma unroll
                    for (int n = 0; n < 2; ++n) acc[a][b][m][n] = (f32x4){0.f, 0.f, 0.f, 0.f};
        cur = nxt; cA = nA; cB = nB; ++ui;
        if constexpr (ALIGN_EPI) { if (wr == 1) PG8_BAR; }
    }
    PG8_WAIT_V(0);
    if constexpr (!ALIGN_EPI) { if (wr == 0) PG8_BAR; }
    PG8_BAR;
#undef PG8_SA
#undef PG8_SB
#undef PG8_STAGE
#undef PG8_LDA
#undef PG8_LDB
#undef PG8_MMA
#undef PG8_WAIT_V
#undef PG8_WAIT_L
#undef PG8_BAR
#undef PG8_SCHED
}
}

namespace att {
constexpr int SHM_V = 64 * 128 * 2, SHM_K = SHM_V;
constexpr int OFF_V = 0, OFF_K = 2 * SHM_V, OFF_WS = 4 * SHM_V, OFF_OST = OFF_WS + 2048, OST_WAVE = 32 * 272, OFF_RPB = OFF_OST + 8 * OST_WAVE, ATT_LDS_END = OFF_RPB + 2048;
static_assert(ATT_LDS_END <= LDSCTL_OFF, "attention LDS map");
constexpr float THR = 11.5f;
#define KSWZ(row, colB) ((row) * 256 + ((colB) ^ (((row) & 7) << 4)))
#define SBAR() __builtin_amdgcn_sched_barrier(0)
__device__ __forceinline__ int crow(int r, int hi) { return (r & 3) + 8 * (r >> 2) + 4 * hi; }
__device__ __forceinline__ void partialSM(f32x16& p0, f32x16& p1, float& m_reg, float& mn, float& alpha) {
    float pmax = p0[0];
#pragma unroll
    for (int r = 1; r < 16; ++r) pmax = fmaxf(pmax, p0[r]);
#pragma unroll
    for (int r = 0; r < 16; ++r) pmax = fmaxf(pmax, p1[r]);
    { auto rr = __builtin_amdgcn_permlane32_swap(__float_as_uint(pmax), __float_as_uint(pmax), false, false);
      pmax = fmaxf(__uint_as_float(rr[0]), __uint_as_float(rr[1])); }
    if (__builtin_expect(__all(pmax - m_reg <= THR), 1)) { mn = m_reg; alpha = 1.f; }
    else { mn = fmaxf(m_reg, pmax); alpha = __builtin_amdgcn_exp2f(m_reg - mn); m_reg = mn; }
#pragma unroll
    for (int r = 0; r < 16; ++r) p0[r] = p0[r] - mn;
#pragma unroll
    for (int r = 0; r < 16; ++r) p1[r] = p1[r] - mn;
#pragma unroll
    for (int r = 0; r < 16; ++r) p0[r] = __builtin_amdgcn_exp2f(p0[r]);
}
__device__ __forceinline__ void finishSM(f32x16& p0, f32x16& p1, float alpha, float& l_reg, bf16x8& pa0, bf16x8& pa1, bf16x8& pa2, bf16x8& pa3) {
#pragma unroll
    for (int r = 0; r < 16; ++r) p1[r] = __builtin_amdgcn_exp2f(p1[r]);
    float ps = 0;
#pragma unroll
    for (int r = 0; r < 16; ++r) ps += p0[r];
#pragma unroll
    for (int r = 0; r < 16; ++r) ps += p1[r];
    { auto rr = __builtin_amdgcn_permlane32_swap(__float_as_uint(ps), __float_as_uint(ps), false, false);
      ps = __uint_as_float(rr[0]) + __uint_as_float(rr[1]); }
    l_reg = l_reg * alpha + ps;
#define PK4(P, BASE, OUT) do { unsigned a0 = cvt_pk_bf16(P[BASE + 0], P[BASE + 1]), a1 = cvt_pk_bf16(P[BASE + 2], P[BASE + 3]);   \
    unsigned b0 = cvt_pk_bf16(P[BASE + 4], P[BASE + 5]), b1 = cvt_pk_bf16(P[BASE + 6], P[BASE + 7]);                              \
    auto r0 = __builtin_amdgcn_permlane32_swap(a0, b0, false, false); auto r1 = __builtin_amdgcn_permlane32_swap(a1, b1, false, false); \
    u32x4 w = {r0[0], r1[0], r0[1], r1[1]}; OUT = __builtin_bit_cast(bf16x8, w); } while (0)
    PK4(p0, 0, pa0); PK4(p0, 8, pa1); PK4(p1, 0, pa2); PK4(p1, 8, pa3);
#undef PK4
}
__device__ __forceinline__ void qkt(f32x16& p0, f32x16& p1, const LAS char* Ks, const bf16x8* qr, int r32, int hi) {
    p0 = f32x16{}; p1 = f32x16{};
#pragma unroll
    for (int d0 = 0; d0 < 8; ++d0) { const int cb = (d0 * 16 + hi * 8) * 2;
        const bf16x8 b0 = *(const LAS bf16x8*)(Ks + KSWZ(r32, cb));
        const bf16x8 b1 = *(const LAS bf16x8*)(Ks + KSWZ(32 + r32, cb));
        p0 = __builtin_amdgcn_mfma_f32_32x32x16_bf16(b0, qr[d0], p0, 0, 0, 0);
        p1 = __builtin_amdgcn_mfma_f32_32x32x16_bf16(b1, qr[d0], p1, 0, 0, 0); }
}
__device__ __forceinline__ int v_st(int k, int c) { const int kk = (k & ~0xC) | ((k & 4) << 1) | ((k & 8) >> 1); return ((kk >> 3) * 4 + (c >> 5)) * 512 + ((kk & 7) * 32 + (c & 31)) * 2; }
__device__ __forceinline__ int v_rd_base(int lane) { return ((lane & 3) << 3) | (((lane >> 2) & 3) << 6) | (((lane >> 4) & 1) << 5) | (((lane >> 5) & 1) << 8); }
constexpr int v_rd_off(int d0, int ks, int half) { return d0 * 512 + ks * 4096 + half * 2048; }
template <int OFF> __device__ __forceinline__ s16x4 tr_read(int vb) {
    s16x4 r; asm volatile("ds_read_b64_tr_b16 %0, %1 offset:%2" : "=&v"(r) : "v"(vb), "i"(OFF) : "memory"); return r;
}
template <int D0> __device__ __forceinline__ void pv_one(f32x16& od, int vb, bf16x8 pa0, bf16x8 pa1, bf16x8 pa2, bf16x8 pa3) {
    const s16x4 l0 = tr_read<v_rd_off(D0, 0, 0)>(vb), h0 = tr_read<v_rd_off(D0, 0, 1)>(vb), l1 = tr_read<v_rd_off(D0, 1, 0)>(vb), h1 = tr_read<v_rd_off(D0, 1, 1)>(vb);
    const s16x4 l2 = tr_read<v_rd_off(D0, 2, 0)>(vb), h2 = tr_read<v_rd_off(D0, 2, 1)>(vb), l3 = tr_read<v_rd_off(D0, 3, 0)>(vb), h3 = tr_read<v_rd_off(D0, 3, 1)>(vb);
    asm volatile("s_waitcnt lgkmcnt(0)" ::: "memory"); SBAR();
#define PK(L, H) (bf16x8){L[0], L[1], L[2], L[3], H[0], H[1], H[2], H[3]}
    od = __builtin_amdgcn_mfma_f32_32x32x16_bf16(pa0, PK(l0, h0), od, 0, 0, 0);
    od = __builtin_amdgcn_mfma_f32_32x32x16_bf16(pa1, PK(l1, h1), od, 0, 0, 0);
    od = __builtin_amdgcn_mfma_f32_32x32x16_bf16(pa2, PK(l2, h2), od, 0, 0, 0);
    od = __builtin_amdgcn_mfma_f32_32x32x16_bf16(pa3, PK(l3, h3), od, 0, 0, 0);
#undef PK
}
__device__ __forceinline__ void pv_d0(f32x16* o, int vb, bf16x8 pa0, bf16x8 pa1, bf16x8 pa2, bf16x8 pa3) {
    pv_one<0>(o[0], vb, pa0, pa1, pa2, pa3); pv_one<1>(o[1], vb, pa0, pa1, pa2, pa3); pv_one<2>(o[2], vb, pa0, pa1, pa2, pa3); pv_one<3>(o[3], vb, pa0, pa1, pa2, pa3);
}

struct Mask { int kind, nb, jlo, pq  , rk0, qr, qc  ; const LAS float* rpb; };
__device__ __forceinline__ void apply_mask(f32x16& p0, f32x16& p1, const Mask& M, int t, int hi) {
    if (t >= M.nb) return;
    const float NEG = -__builtin_inff();
#define CR(r) (((r) & 3) + 8 * ((r) >> 2))
    if (M.kind == 0) {
        const int jt = M.jlo + t;
        if (jt < 2) { const int lim = M.pq - 64 * jt - 4 * hi;
#pragma unroll
            for (int r = 0; r < 16; ++r) { p0[r] = (CR(r) >= lim) ? p0[r] : NEG; p1[r] = (CR(r) + 32 >= lim) ? p1[r] : NEG; }
        } else if (jt >= 4) { const int lim = M.pq - 64 * (jt - 4) - 4 * hi;
#pragma unroll
            for (int r = 0; r < 16; ++r) { p0[r] = (CR(r) <= lim) ? p0[r] : NEG; p1[r] = (CR(r) + 32 <= lim) ? p1[r] : NEG; }
        }
    } else if (M.kind == 1) {
        const int kr = M.rk0 + t; int r0q = M.qr - 4; r0q = r0q < 0 ? 0 : (r0q > 120 ? 120 : r0q);
        const bool rowok = (kr >= r0q) && (kr < r0q + 8);
        int dr = kr - M.qr + 7; dr = dr < 0 ? 0 : (dr > 14 ? 14 : dr);
        int c0 = M.qc - 8; c0 = c0 < 0 ? 0 : (c0 > 48 ? 48 : c0);
        const int c0h = rowok ? (c0 - 4 * hi) : 1000;
        const LAS float* tb = M.rpb + dr * 31 + (15 - M.qc) + 4 * hi;
#pragma unroll
        for (int r = 0; r < 16; ++r) { const float b0 = tb[CR(r)]; p0[r] = ((unsigned)(CR(r) - c0h) < 16u) ? p0[r] + b0 : NEG; }
        SBAR();
#pragma unroll
        for (int r = 0; r < 16; ++r) { const float b1 = tb[CR(r) + 32]; p1[r] = ((unsigned)(CR(r) + 32 - c0h) < 16u) ? p1[r] + b1 : NEG; }
    }
#undef CR
}

__device__ __forceinline__ void attn_unit(const bf16_t* __restrict__ P, bf16_t* __restrict__ MIX, const float* __restrict__ sinkp, const float* __restrict__ rpbp,
                                          const float* __restrict__ na_qgain, const float* __restrict__ wa_qgain, const float* __restrict__ rope,
                                          int kind, int b, int i1, int i2, LAS char* lds) {
    int tid = threadIdx.x; asm volatile("" : "+v"(tid));
    const int wid = __builtin_amdgcn_readfirstlane(tid >> 6), lane = tid & 63, r32 = lane & 31, hi = lane >> 5;
    LAS char* V_lds = lds + OFF_V; LAS char* K_lds = lds + OFF_K;
    LAS float* wsf = (LAS float*)(lds + OFF_WS) + wid * 64; LAS float* li_l = wsf; LAS float* al_l = wsf + 32;
    LAS float* rpb_l = (LAS float*)(lds + OFF_RPB);
    int qbase, qcol, ocol, nb, row0, kcol, vcol; float sink2 = -__builtin_inff();
    Mask MK; MK.kind = kind; MK.jlo = 0; MK.pq = 0; MK.rk0 = 0; MK.qr = 0; MK.qc = 0; MK.rpb = rpb_l;
    if (kind == 0) {
        const int n = i1, kvh = i2 >> 1, gp = i2 & 1, g = 2 * gp + (wid >> 2), qh = 4 * kvh + g, p0q = 32 * (wid & 3);
        qbase = b * SEQ + n * 128 + p0q; qcol = PC_WQ + qh * 128; ocol = 1024 + qh * 128;
        const int jlo = (n == 0) ? 2 : 0, jhi = (n == SEQ / 128 - 1) ? 4 : 6; nb = jhi - jlo; row0 = b * SEQ + (n - 1) * 128 + 64 * jlo;
        kcol = PC_WK + kvh * 128; vcol = PC_WV + kvh * 128; sink2 = sinkp[qh] * LOG2E;
        MK.jlo = jlo; MK.pq = p0q + r32;
    } else if (kind == 1) {
        const int r = 4 * i1, h = i2, qr = r + (wid >> 1), c32 = 32 * (wid & 1);
        qbase = b * SEQ + qr * 64 + c32; qcol = PC_NQ + h * 128; ocol = h * 128;
        int rk0 = r - 4; rk0 = rk0 < 0 ? 0 : (rk0 > 116 ? 116 : rk0); nb = 12; row0 = b * SEQ + rk0 * 64;
        kcol = PC_NK + h * 128; vcol = PC_NV + h * 128;
        MK.rk0 = rk0; MK.qr = qr; MK.qc = c32 + r32;
        if (tid < 15 * 31) rpb_l[tid] = rpbp[h * (15 * 31) + tid] * LOG2E;
    } else if (kind == 2) {
        const int h = i1; qbase = ML + b * NCTX + 32 * wid; qcol = PC_NQ + h * 128; ocol = h * 128; nb = 0; row0 = 0; kcol = PC_NK + h * 128; vcol = PC_NV + h * 128;
    } else {
        const int qh = i1, kvh = qh >> 2; qbase = ML + b * NCTX + 32 * wid; qcol = PC_WQ + qh * 128; ocol = 1024 + qh * 128; nb = 0; row0 = 0;
        kcol = PC_WK + kvh * 128; vcol = PC_WV + kvh * 128; sink2 = sinkp[qh] * LOG2E;
    }
    MK.nb = nb;
    const float* qgain = (kind == 0 || kind == 3) ? wa_qgain : na_qgain;
    const int crow0 = ML + b * NCTX, NT = nb + 4;
    float m_reg = -1e30f, l_reg = 0; f32x16 o[4] = {}; bf16x8 qr[8];
    {
        const bf16_t* Qw = P + (size_t)(qbase + r32) * INW + qcol + hi * 8;
        float qf[8][8]; float ssq = 0.f;
#pragma unroll
        for (int d0 = 0; d0 < 8; ++d0) { const u32x4 raw = *(const u32x4*)(Qw + d0 * 16);
            qf[d0][0] = __builtin_bit_cast(float, raw.x << 16); qf[d0][1] = __builtin_bit_cast(float, raw.x & 0xffff0000u); qf[d0][2] = __builtin_bit_cast(float, raw.y << 16); qf[d0][3] = __builtin_bit_cast(float, raw.y & 0xffff0000u);
            qf[d0][4] = __builtin_bit_cast(float, raw.z << 16); qf[d0][5] = __builtin_bit_cast(float, raw.z & 0xffff0000u); qf[d0][6] = __builtin_bit_cast(float, raw.w << 16); qf[d0][7] = __builtin_bit_cast(float, raw.w & 0xffff0000u);
#pragma unroll
            for (int j = 0; j < 8; ++j) ssq += qf[d0][j] * qf[d0][j]; }
        ssq += __shfl_xor(ssq, 32);
        const float rstd = QSCALE / sqrtf(ssq * (1.0f / 128.0f) + 1e-6f);
        const float* gq = qgain + hi * 8;
#pragma unroll
        for (int d0 = 0; d0 < 8; ++d0) { const f32x4 g0 = *(const f32x4*)(gq + d0 * 16), g1 = *(const f32x4*)(gq + d0 * 16 + 4);
            qf[d0][0] *= rstd * g0.x; qf[d0][1] *= rstd * g0.y; qf[d0][2] *= rstd * g0.z; qf[d0][3] *= rstd * g0.w; qf[d0][4] *= rstd * g1.x; qf[d0][5] *= rstd * g1.y; qf[d0][6] *= rstd * g1.z; qf[d0][7] *= rstd * g1.w; }
        if (kind == 0) {
            const int t = (qbase + r32) & (SEQ - 1);
#pragma unroll
            for (int hp = 0; hp < 2; ++hp) { const int pos = hp ? (t & 63) : (t >> 6);
#pragma unroll
                for (int dd = 0; dd < 2; ++dd) { const int da = 4 * hp + dd, db = da + 2;
                    const float* tp = rope + ((size_t)pos * 32 + 16 * dd + 8 * hi) * 2;
#pragma unroll
                    for (int j = 0; j < 8; ++j) { const float c = tp[2 * j], s = tp[2 * j + 1], x1 = qf[da][j], x2 = qf[db][j]; qf[da][j] = x1 * c - x2 * s; qf[db][j] = x2 * c + x1 * s; } } }
        }
#pragma unroll
        for (int d0 = 0; d0 < 8; ++d0) { u32x4 w; w.x = cvt_pk_bf16(qf[d0][0], qf[d0][1]); w.y = cvt_pk_bf16(qf[d0][2], qf[d0][3]); w.z = cvt_pk_bf16(qf[d0][4], qf[d0][5]); w.w = cvt_pk_bf16(qf[d0][6], qf[d0][7]); qr[d0] = __builtin_bit_cast(bf16x8, w); }
    }
    const int sr = tid >> 4, sc = (tid & 15) * 8, vst0 = v_st(sr, sc), vst1 = v_st(32 + sr, sc);
    const int vb0 = (int)(unsigned)(size_t)V_lds + v_rd_base(lane);
#define TROW(t) (((t) < nb) ? (row0 + 64 * (t)) : (crow0 + 64 * ((t) - nb)))
#define RESC(a) do { if (__any((a) < 1.f)) { if (hi == 0) al_l[r32] = (a); asm volatile("s_waitcnt lgkmcnt(0)" ::: "memory"); \
    _Pragma("unroll") for (int d = 0; d < 4; ++d) _Pragma("unroll") for (int r = 0; r < 16; ++r) o[d][r] *= al_l[crow(r, hi)]; } } while (0)
#if ATT_PIPE2
    struct { bf16x8 vs0, vs1, ks0, ks1; } sr_[2];
#define SLOAD(i, t) do { const bf16_t* _b = P + (size_t)(TROW(t) + sr) * INW + sc; \
    sr_[i].vs0 = *(const bf16x8*)(_b + vcol); sr_[i].vs1 = *(const bf16x8*)(_b + (size_t)32 * INW + vcol); \
    sr_[i].ks0 = *(const bf16x8*)(_b + kcol); sr_[i].ks1 = *(const bf16x8*)(_b + (size_t)32 * INW + kcol); } while (0)
#define SWRITE(bb, i) do { *(LAS bf16x8*)(V_lds + (bb) * SHM_V + vst0) = sr_[i].vs0; *(LAS bf16x8*)(V_lds + (bb) * SHM_V + vst1) = sr_[i].vs1; const int kc_ = sc * 2; \
    *(LAS bf16x8*)(K_lds + (bb) * SHM_K + KSWZ(sr, kc_)) = sr_[i].ks0; *(LAS bf16x8*)(K_lds + (bb) * SHM_K + KSWZ(32 + sr, kc_)) = sr_[i].ks1; } while (0)
#define SWAIT() asm volatile("s_waitcnt vmcnt(4)" ::: "memory")
    f32x16 pA0, pA1, pB0, pB1; float mnA, mnB, alA, alB; bf16x8 pa0, pa1, pa2, pa3;
    constexpr int SE = 0, SO = 1;
    SLOAD(SE, 0); asm volatile("s_waitcnt vmcnt(0)" ::: "memory"); SWRITE(0, SE); __syncthreads();
    qkt(pA0, pA1, K_lds, qr, r32, hi); apply_mask(pA0, pA1, MK, 0, hi); partialSM(pA0, pA1, m_reg, mnA, alA);
    SLOAD(SO, 1); if (2 < NT) SLOAD(SE, 2);
    SWAIT(); SWRITE(1, SO); __syncthreads();
    for (int j = 1; j + 1 < NT; j += 2) {
        SBAR(); qkt(pB0, pB1, K_lds + SHM_K, qr, r32, hi);
        finishSM(pA0, pA1, alA, l_reg, pa0, pa1, pa2, pa3); SBAR();
        SLOAD(SO, j + 2); SBAR();
        pv_d0(o, vb0, pa0, pa1, pa2, pa3); apply_mask(pB0, pB1, MK, j, hi); partialSM(pB0, pB1, m_reg, mnB, alB);
        __syncthreads(); SWAIT(); SWRITE(0, SE);
        RESC(alB); __syncthreads();
        SBAR(); qkt(pA0, pA1, K_lds, qr, r32, hi);
        finishSM(pB0, pB1, alB, l_reg, pa0, pa1, pa2, pa3); SBAR();
        if (j + 3 < NT) SLOAD(SE, j + 3); SBAR();
        pv_d0(o, vb0 + SHM_V, pa0, pa1, pa2, pa3); apply_mask(pA0, pA1, MK, j + 1, hi); partialSM(pA0, pA1, m_reg, mnA, alA);
        __syncthreads(); SWAIT(); SWRITE(1, SO);
        RESC(alA); __syncthreads();
    }
    SBAR(); qkt(pB0, pB1, K_lds + SHM_K, qr, r32, hi);
    finishSM(pA0, pA1, alA, l_reg, pa0, pa1, pa2, pa3); SBAR();
    pv_d0(o, vb0, pa0, pa1, pa2, pa3); apply_mask(pB0, pB1, MK, NT - 1, hi); partialSM(pB0, pB1, m_reg, mnB, alB);
    __syncthreads(); RESC(alB);
    finishSM(pB0, pB1, alB, l_reg, pa0, pa1, pa2, pa3); SBAR();
    pv_d0(o, vb0 + SHM_V, pa0, pa1, pa2, pa3);
#undef SWAIT
#else
    bf16x8 vs0, vs1, ks0, ks1;
#define SLOAD(t) do { const bf16_t* _b = P + (size_t)(TROW(t) + sr) * INW + sc; \
    vs0 = *(const bf16x8*)(_b + vcol); vs1 = *(const bf16x8*)(_b + (size_t)32 * INW + vcol); \
    ks0 = *(const bf16x8*)(_b + kcol); ks1 = *(const bf16x8*)(_b + (size_t)32 * INW + kcol); } while (0)
#define SWRITE(bb) do { *(LAS bf16x8*)(V_lds + (bb) * SHM_V + vst0) = vs0; *(LAS bf16x8*)(V_lds + (bb) * SHM_V + vst1) = vs1; const int kc_ = sc * 2; \
    *(LAS bf16x8*)(K_lds + (bb) * SHM_K + KSWZ(sr, kc_)) = ks0; *(LAS bf16x8*)(K_lds + (bb) * SHM_K + KSWZ(32 + sr, kc_)) = ks1; } while (0)
    SLOAD(0); asm volatile("s_waitcnt vmcnt(0)" ::: "memory"); SWRITE(0); SLOAD(1); __syncthreads();
    for (int j = 0; j < NT; ++j) {
        const int bsel = j & 1;
        f32x16 p0, p1; float mn, al; bf16x8 pa0, pa1, pa2, pa3;
        qkt(p0, p1, K_lds + bsel * SHM_K, qr, r32, hi);
        apply_mask(p0, p1, MK, j, hi);
        partialSM(p0, p1, m_reg, mn, al);
        RESC(al);
        finishSM(p0, p1, al, l_reg, pa0, pa1, pa2, pa3);
        pv_d0(o, vb0 + bsel * SHM_V, pa0, pa1, pa2, pa3);
        if (j + 1 < NT) { asm volatile("s_waitcnt vmcnt(0)" ::: "memory"); SWRITE(bsel ^ 1); if (j + 2 < NT) SLOAD(j + 2); }
        __syncthreads();
    }
#endif
    l_reg += __builtin_amdgcn_exp2f(sink2 - m_reg);
    if (hi == 0) li_l[r32] = l_reg; asm volatile("s_waitcnt lgkmcnt(0)" ::: "memory");
    LAS char* ost = lds + OFF_OST + wid * OST_WAVE;
#pragma unroll
    for (int r = 0; r < 16; ++r) { const int orow = crow(r, hi); const float rl = __builtin_amdgcn_rcpf(li_l[orow]);
#pragma unroll
        for (int d0 = 0; d0 < 4; ++d0) *(LAS unsigned short*)(ost + orow * 272 + (d0 * 32 + r32) * 2) = (unsigned short)f2bf(o[d0][r] * rl); }
    asm volatile("s_waitcnt lgkmcnt(0)" ::: "memory");
#pragma unroll
    for (int i = 0; i < 8; ++i) { const int id = i * 64 + lane, rr = id >> 4, c16 = id & 15;
        const u32x4 v = *(const LAS u32x4*)(ost + rr * 272 + c16 * 16);
        *(u32x4*)(MIX + (size_t)(qbase + rr) * DM + ocol + c16 * 8) = v; }
#undef TROW
#undef SLOAD
#undef SWRITE
#undef RESC
}
}

#define XB_TMO      128
#define XB_XCNT(j)  (256  + 64 * (j))
#define XB_XSUB(j)  (1280 + 64 * (j))
#define XB_XGEN(j)  (2304 + 64 * (j))
#define XB_TOP      3328
#define XB_TOPGEN   3392
#define XCD_BAR_WORDS 3456
#define XB_SPIN_CAP (1u << 18)
__device__ __forceinline__ unsigned xb_ld(unsigned* p)              { return __hip_atomic_load(p, __ATOMIC_RELAXED, __HIP_MEMORY_SCOPE_AGENT); }
__device__ __forceinline__ unsigned xb_add(unsigned* p, unsigned v) { return __hip_atomic_fetch_add(p, v, __ATOMIC_RELAXED, __HIP_MEMORY_SCOPE_AGENT); }
__device__ __forceinline__ unsigned xb_xcc_id() { return (unsigned)__builtin_amdgcn_s_getreg((3 << 11) | 20) & 0xFu; }
#define XB_SPIN(cond, bar) do { unsigned _sp = 0; while (cond) { __builtin_amdgcn_s_sleep(1); \
    if ((++_sp & 255u) == 0u) { if (xb_ld(&(bar)[XB_TMO])) break; if (_sp > XB_SPIN_CAP) { atomicAdd(&(bar)[XB_TMO], 1u); break; } } } } while (0)
struct XcdBarrier { unsigned* bar; unsigned x; volatile LAS unsigned* st; };
__device__ __forceinline__ XcdBarrier xcd_barrier_post(unsigned* bar, volatile LAS unsigned* st) {
    XcdBarrier b; b.bar = bar; b.x = xb_xcc_id(); b.st = st;
    if (threadIdx.x == 0) (void)xb_add(&bar[XB_XCNT(b.x)], 1u);
    return b;
}
__device__ __forceinline__ void xcd_barrier_complete(unsigned* bar, unsigned x, unsigned& nloc, unsigned& nx) {
    const unsigned G = gridDim.x * gridDim.y * gridDim.z;
    unsigned sum, cnt, mine, sp = 0u;
    for (;;) {
        sum = 0u; cnt = 0u; mine = 0u;
#pragma unroll
        for (unsigned j = 0; j < 16; ++j) { const unsigned c = xb_ld(&bar[XB_XCNT(j)]); sum += c; cnt += (c > 0u) ? 1u : 0u; mine = (j == x) ? c : mine; }
        if (sum == G) break;
        __builtin_amdgcn_s_sleep(1);
        if ((++sp & 255u) == 0u) { if (xb_ld(&bar[XB_TMO])) break; if (sp > XB_SPIN_CAP) { atomicAdd(&bar[XB_TMO], 1u); break; } }
    }
    nloc = mine > 0u ? mine : 1u; nx = cnt > 0u ? cnt : 1u;
}
__device__ __forceinline__ void xcd_barrier(const XcdBarrier& b) {
    asm volatile("s_waitcnt vmcnt(0)" ::: "memory");
    __syncthreads();
    if (threadIdx.x == 0) {
        unsigned* bar = b.bar;
        __builtin_amdgcn_s_waitcnt(0);
        unsigned nloc = b.st[0], nx = b.st[1];
        if (nloc == 0u) { xcd_barrier_complete(bar, b.x, nloc, nx); b.st[0] = nloc; b.st[1] = nx; }
        const unsigned old = xb_add(&bar[XB_XSUB(b.x)], 1u);
        const unsigned gen = old / nloc;
        if (old + 1u == (gen + 1u) * nloc) {
            __builtin_amdgcn_fence(__ATOMIC_RELEASE, "agent");
            asm volatile("s_waitcnt vmcnt(0)" ::: "memory");
            const unsigned og = xb_add(&bar[XB_TOP], 1u);
            const unsigned tg = og / nx;
            if (og + 1u == (tg + 1u) * nx) xb_add(&bar[XB_TOPGEN], 1u);
            else XB_SPIN(xb_ld(&bar[XB_TOPGEN]) == tg, bar);
            __builtin_amdgcn_fence(__ATOMIC_ACQUIRE, "agent");
            xb_add(&bar[XB_XGEN(b.x)], 1u);
            asm volatile("s_waitcnt vmcnt(0)" ::: "memory");
        } else {
            XB_SPIN(xb_ld(&bar[XB_XGEN(b.x)]) == gen, bar);
            __builtin_amdgcn_fence(__ATOMIC_ACQUIRE, "agent");
            asm volatile("s_waitcnt vmcnt(0)" ::: "memory");
        }
    }
    __syncthreads();
}

__device__ __forceinline__ int wt_dest_row(int n0, int N, bool swiglu) {
    if (!swiglu) return n0;
    const int half = N / 2; const int j = (n0 < half) ? n0 : n0 - half; return 256 * (j >> 7) + (j & 127) + ((n0 < half) ? 0 : 128);
}
__device__ __forceinline__ void transpose_item(const float* __restrict__ W, int K, int N, bf16_t* __restrict__ WT, bool swiglu, int item, int lane) {
    const int nblk = N / 64, kb = item / nblk, nbi = item - kb * nblk, k0 = 64 * kb, n0 = 64 * nbi;
    const int k8 = lane & 7, n4 = lane >> 3;
    const float* src = W + (size_t)(k0 + 8 * k8) * N + n0 + 4 * n4;
    f32x4 v[2][8];
#pragma unroll
    for (int h = 0; h < 2; ++h)
#pragma unroll
        for (int i = 0; i < 8; ++i) v[h][i] = __builtin_nontemporal_load((const f32x4*)(src + (size_t)i * N + 32 * h));
#pragma unroll
    for (int h = 0; h < 2; ++h) { const int d0 = wt_dest_row(n0 + 32 * h, N, swiglu);
        bf16_t* dst = WT + (size_t)(d0 + 4 * n4) * K + k0 + 8 * k8;
#pragma unroll
        for (int j = 0; j < 4; ++j) { u32x4 o; o.x = cvt_pk_bf16(v[h][0][j], v[h][1][j]); o.y = cvt_pk_bf16(v[h][2][j], v[h][3][j]); o.z = cvt_pk_bf16(v[h][4][j], v[h][5][j]); o.w = cvt_pk_bf16(v[h][6][j], v[h][7][j]);
            *(u32x4*)(dst + (size_t)j * K) = o; } }
}
__device__ __forceinline__ float silu_f(float x) { return x / (1.0f + __expf(-x)); }
__device__ __forceinline__ void sincos_small(float a, float& c, float& s) {
    const float n = rintf(a * 0.63661977236758134f);
    float r = fmaf(-n, 1.57079637050628662109375f, a); r = fmaf(n, 4.37113900018624283e-8f, r);
    const float z = r * r;
    const float sp = r + r * z * (-1.6666654611e-1f + z * (8.3321608736e-3f + z * (-1.9515295891e-4f)));
    const float cp = 1.0f - 0.5f * z + z * z * (4.166664568298827e-2f + z * (-1.388731625493765e-3f + z * 2.443315711809948e-5f));
    const int q = ((int)n) & 3;
    c = (q == 0) ? cp : (q == 1) ? -sp : (q == 2) ? -cp : sp;
    s = (q == 0) ? sp : (q == 1) ? cp : (q == 2) ? -sp : -cp;
}

__device__ __forceinline__ void norm_phase(const float* xl, const float* xc, float* xcw, const float* part, const float* g, const float* modl, int shift_chunk, int scale_chunk, bf16_t* H, int nrows, int gw, int ngw, int lane) {
    for (int row = gw; row < nrows; row += ngw) {
        const float* xr = (row < ML) ? xl + (size_t)row * DM : xc + (size_t)(row - ML) * DM;
        const int s = (row < ML) ? (row >> 13) : 4;
        const f32x4* sh = (const f32x4*)(modl + (size_t)s * MODW + shift_chunk * DM); const f32x4* scp = (const f32x4*)(modl + (size_t)s * MODW + scale_chunk * DM);
        f32x4 v[8]; float ss = 0.f;
#pragma unroll
        for (int j = 0; j < 8; ++j) v[j] = ((const f32x4*)xr)[lane + 64 * j];
        if (part != nullptr && row >= ML) {
            const f32x4* pp = (const f32x4*)(part + (size_t)(row - ML) * DM);
#pragma unroll
            for (int j = 0; j < 8; ++j) { v[j] += (pp[lane + 64 * j] + pp[(size_t)MC * DM / 4 + lane + 64 * j]) + (pp[(size_t)2 * MC * DM / 4 + lane + 64 * j] + pp[(size_t)3 * MC * DM / 4 + lane + 64 * j]);
                ((f32x4*)(xcw + (size_t)(row - ML) * DM))[lane + 64 * j] = v[j]; }
        }
#pragma unroll
        for (int j = 0; j < 8; ++j) ss += (v[j].x * v[j].x + v[j].y * v[j].y) + (v[j].z * v[j].z + v[j].w * v[j].w);
        const float rstd = 1.0f / sqrtf(wave_sum(ss) * (1.0f / DM) + 1e-6f);
        u32x2* o8 = (u32x2*)(H + (size_t)row * DM) + lane;
#pragma unroll
        for (int j = 0; j < 8; ++j) { const f32x4 gj = ((const f32x4*)g)[lane + 64 * j], sj = scp[lane + 64 * j], hj = sh[lane + 64 * j];
            const f32x4 y = v[j] * rstd * gj * (sj + 1.0f) + hj;
            u32x2 w; w.x = cvt_pk_bf16(y.x, y.y); w.y = cvt_pk_bf16(y.z, y.w); o8[64 * j] = w; }
    }
}

__device__ __forceinline__ void prep_phase(bf16_t* P, const float* na_gain, const float* wa_gain, const float* rope, int gthread, int nthreads) {
    const int sub = gthread & 15;
    for (int item = gthread >> 4; item < MT * 6; item += (nthreads >> 4)) {
        const int row = item / 6, hx = item - row * 6;
        int col; const bool isq = false; bool iswa;
        if (hx < 4) { col = PC_NK + 128 * hx; iswa = false; }
        else { col = PC_WK + 128 * (hx - 4); iswa = true; }
        bf16_t* p = P + (size_t)row * INW + col + 8 * sub;
        const u32x4 raw = *(const u32x4*)p;
        float v[8];
        v[0] = __builtin_bit_cast(float, raw.x << 16); v[1] = __builtin_bit_cast(float, raw.x & 0xffff0000u);
        v[2] = __builtin_bit_cast(float, raw.y << 16); v[3] = __builtin_bit_cast(float, raw.y & 0xffff0000u);
        v[4] = __builtin_bit_cast(float, raw.z << 16); v[5] = __builtin_bit_cast(float, raw.z & 0xffff0000u);
        v[6] = __builtin_bit_cast(float, raw.w << 16); v[7] = __builtin_bit_cast(float, raw.w & 0xffff0000u);
        float ss = 0.f;
#pragma unroll
        for (int j = 0; j < 8; ++j) ss += v[j] * v[j];
        ss += __shfl_xor(ss, 1); ss += __shfl_xor(ss, 2); ss += __shfl_xor(ss, 4); ss += __shfl_xor(ss, 8);
        const float rstd = 1.0f / sqrtf(ss * (1.0f / 128.0f) + 1e-6f);
        const float* gn = (iswa ? wa_gain : na_gain) + (isq ? 0 : 128) + 8 * sub;
        const f32x4 g0 = *(const f32x4*)gn, g1 = *(const f32x4*)(gn + 4);
        v[0] *= rstd * g0.x; v[1] *= rstd * g0.y; v[2] *= rstd * g0.z; v[3] *= rstd * g0.w; v[4] *= rstd * g1.x; v[5] *= rstd * g1.y; v[6] *= rstd * g1.z; v[7] *= rstd * g1.w;
        if (iswa) {
            float pv[8];
#pragma unroll
            for (int j = 0; j < 8; ++j) pv[j] = __shfl_xor(v[j], 4);
            if (row < ML) {
                const int t = row & (SEQ - 1), pos = (sub >= 8) ? (t & 63) : (t >> 6);
                const int i0 = (8 * sub) & 31; const bool first = ((8 * sub) & 63) < 32;
                const float* tp = rope + ((size_t)pos * 32 + i0) * 2;
#pragma unroll
                for (int j = 0; j < 8; ++j) { const float c = tp[2 * j], s = tp[2 * j + 1]; v[j] = first ? (v[j] * c - pv[j] * s) : (v[j] * c + pv[j] * s); }
            }
        }
        if (isq) {
#pragma unroll
            for (int j = 0; j < 8; ++j) v[j] *= QSCALE;
        }
        u32x4 o; o.x = cvt_pk_bf16(v[0], v[1]); o.y = cvt_pk_bf16(v[2], v[3]); o.z = cvt_pk_bf16(v[4], v[5]); o.w = cvt_pk_bf16(v[6], v[7]);
        *(u32x4*)p = o;
    }
}

constexpr int POOL_A_OFF = 0, POOL_AS = 272, POOL_B_OFF = 256 * POOL_AS, POOL_LDS_END = POOL_B_OFF + 128 * POOL_AS;
static_assert(POOL_LDS_END <= LDSCTL_OFF, "pool LDS map");
template <int WIN> __device__ __forceinline__ void pool_a_tile(const bf16_t* __restrict__ up  , int t0, int L, int tid, LAS char* lds) {
#pragma unroll 2
    for (int it = 0; it < 8; ++it) { const int item = it * 512 + tid, row = item >> 4, cg = item & 15, t = t0 + row;
        float s[8], ctr[8];
#pragma unroll
        for (int j = 0; j < 8; ++j) s[j] = 0.f;
#pragma unroll
        for (int w = 0; w < WIN; ++w) { const int tt = t - WIN / 2 + w; const bool ok = (tt >= 0) && (tt < L); const int tc = tt < 0 ? 0 : (tt > L - 1 ? L - 1 : tt);
            const u32x4 raw = *(const u32x4*)(up + (size_t)tc * INW + 8 * cg); const float m = ok ? 1.f : 0.f;
            float f[8]; f[0] = __builtin_bit_cast(float, raw.x << 16); f[1] = __builtin_bit_cast(float, raw.x & 0xffff0000u); f[2] = __builtin_bit_cast(float, raw.y << 16); f[3] = __builtin_bit_cast(float, raw.y & 0xffff0000u);
            f[4] = __builtin_bit_cast(float, raw.z << 16); f[5] = __builtin_bit_cast(float, raw.z & 0xffff0000u); f[6] = __builtin_bit_cast(float, raw.w << 16); f[7] = __builtin_bit_cast(float, raw.w & 0xffff0000u);
#pragma unroll
            for (int j = 0; j < 8; ++j) { s[j] = fmaf(f[j], m, s[j]); if (w == WIN / 2) ctr[j] = f[j]; } }
        int lo = t - WIN / 2; lo = lo < 0 ? 0 : lo; int hi_ = t + WIN / 2 - 1; hi_ = hi_ > L - 1 ? L - 1 : hi_;
        const float inv = 1.0f / (float)(hi_ - lo + 1);
        u32x4 o; o.x = cvt_pk_bf16(s[0] * inv - ctr[0], s[1] * inv - ctr[1]); o.y = cvt_pk_bf16(s[2] * inv - ctr[2], s[3] * inv - ctr[3]);
        o.z = cvt_pk_bf16(s[4] * inv - ctr[4], s[5] * inv - ctr[5]); o.w = cvt_pk_bf16(s[6] * inv - ctr[6], s[7] * inv - ctr[7]);
        *(LAS u32x4*)(lds + POOL_A_OFF + row * POOL_AS + cg * 16) = o; }
}
__device__ __forceinline__ void pool_unit(const bf16_t* __restrict__ P, bf16_t* __restrict__ MIX, const float* __restrict__ pw, const float* __restrict__ pscale, int pm, int g, LAS char* lds) {
    int tid = threadIdx.x; asm volatile("" : "+v"(tid));
    const int wid = tid >> 6, lane = tid & 63, r32 = lane & 31, hi = lane >> 5;
    const int rowbase = pm * 256;
    int seq0, L; if (pm < ML / 256) { seq0 = (pm >> 5) * SEQ; L = SEQ; } else { seq0 = ML + (pm - ML / 256) * NCTX; L = NCTX; }
    __syncthreads();
    { const bf16_t* up = P + (size_t)seq0 * INW + PC_U + g * 128; const int t0 = rowbase - seq0;
      if (g == 0) pool_a_tile<2>(up, t0, L, tid, lds); else if (g == 1) pool_a_tile<4>(up, t0, L, tid, lds); else if (g == 2) pool_a_tile<8>(up, t0, L, tid, lds); else pool_a_tile<16>(up, t0, L, tid, lds);
      for (int idx = tid; idx < 128 * 128; idx += 512) { const int cc = idx >> 7, e = idx & 127;
          *(LAS unsigned short*)(lds + POOL_B_OFF + e * POOL_AS + cc * 2) = (unsigned short)f2bf(pw[(size_t)g * 16384 + idx]); } }
    __syncthreads();
    f32x16 acc[4] = {};
#pragma unroll
    for (int ks = 0; ks < 8; ++ks) { const bf16x8 a = *(const LAS bf16x8*)(lds + POOL_A_OFF + (32 * wid + r32) * POOL_AS + (16 * ks + 8 * hi) * 2);
#pragma unroll
        for (int nbk = 0; nbk < 4; ++nbk) { const bf16x8 bb = *(const LAS bf16x8*)(lds + POOL_B_OFF + (32 * nbk + r32) * POOL_AS + (16 * ks + 8 * hi) * 2);
            acc[nbk] = __builtin_amdgcn_mfma_f32_32x32x16_bf16(a, bb, acc[nbk], 0, 0, 0); } }
#pragma unroll
    for (int nbk = 0; nbk < 4; ++nbk) { const int e = 32 * nbk + r32; const float sc = pscale[g * 128 + e];
#pragma unroll
        for (int r = 0; r < 16; ++r) { const int row = rowbase + 32 * wid + att::crow(r, hi);
            MIX[(size_t)row * DM + 512 + g * 128 + e] = (bf16_t)f2bf(acc[nbk][r] * sc); } }
}

constexpr int NPH = 1 + 11 * DEPTH;
struct Args { const float* in[19]; float* out; unsigned char* ws; int ph_lo, ph_hi; };

template <int PHMASK> __global__ void __launch_bounds__(512, 2) fwd_kernel(Args args) {
    extern __shared__ __attribute__((aligned(16))) unsigned char lds_raw[];
    LAS unsigned char* lds = (LAS unsigned char*)lds_raw;
    const int G = gridDim.x, ngw = G * 8;
#define PHASE_IDS() int tid = threadIdx.x; asm volatile("" : "+v"(tid)); const int lane = tid & 63, wave = __builtin_amdgcn_readfirstlane(tid >> 6); \
    int bx = blockIdx.x; asm volatile("" : "+s"(bx)); const int vcu = (G % 8 == 0) ? (bx % 8) * (G / 8) + bx / 8 : bx; const int gw = vcu * 8 + wave; (void)lane; (void)gw; (void)vcu
    unsigned char* ws = args.ws;
    unsigned* ctl = (unsigned*)(ws + WS_CTL);
    float* MOD = (float*)(ws + WS_MOD);
    float* ROPE = (float*)(ws + WS_ROPE);
    float* XC = (float*)(ws + WS_XC);
    float* PART = (float*)(ws + WS_PART);
    float* DUML = (float*)(ws + WS_END); float* DUMC = (float*)(ws + WS_END + 256 * MiB);
    bf16_t* H = (bf16_t*)(ws + WS_H); bf16_t* HID = (bf16_t*)(ws + WS_HID); bf16_t* P = (bf16_t*)(ws + WS_P); bf16_t* MIX = (bf16_t*)(ws + WS_MIX);
    const float* x_in = args.in[0]; const float* c_in = args.in[1]; const float* ctx_in = args.in[2]; const float* cctx_in = args.in[3];
    const float* w_mod = args.in[4]; const float* b_mod = args.in[5]; const float* norm_w = args.in[6];
    const float* na_gain = args.in[13]; const float* na_rpb = args.in[14]; const float* pool_w = args.in[15]; const float* pool_scale = args.in[16];
    const float* wa_gain = args.in[17]; const float* wa_sink = args.in[18];
    float* xout = args.out;

    { const int t0 = threadIdx.x; if (t0 < 128) ((LAS unsigned*)(lds + LDSCTL_OFF))[t0] = 0u; }
    __syncthreads();
    const int lo = args.ph_lo, hi = args.ph_hi;
#if MK_SINGLE
    XcdBarrier bar = xcd_barrier_post(ctl + CW_BAR, (volatile LAS unsigned*)(lds + LDSCTL_OFF + 32));
#define GRID_BAR() xcd_barrier(bar)
#else
#define GRID_BAR() do { } while (0)
#endif
#define IN(k) (lo <= (k) && (k) < hi)
#define PHON(k) ((PHMASK >> (k)) & 1)
#define DUPREP(k) _Pragma("unroll") for (int rep = 0; rep <= ((DUPMASK >> (k)) & 1); ++rep)
#define ISDUMMY(k) (rep < ((DUPMASK >> (k)) & 1))
#define SEAM(k) do { if (IN((k) + 1)) GRID_BAR(); } while (0)

    if (PHON(0) && IN(0)) {
        PHASE_IDS();
        LAS float* scr = (LAS float*)(lds + wave * 16384);
        constexpr int I_WI = (DM / 64) * (2 * DFF / 64), I_WO = (DFF / 64) * (DM / 64), I_IN = (DM / 64) * (INW / 64), I_OUT = (DM / 64) * (DM / 64);
        constexpr int I_LAYER = 2 * I_WI + 2 * I_WO + I_IN + I_OUT;
        DUPREP(0)
        for (int it = gw; it < DEPTH * I_LAYER; it += ngw) {
            const int l = it / I_LAYER; int r = it - l * I_LAYER;
            unsigned char* wl = ws + WS_W + (size_t)l * W_LAYER;
            if (r < I_WI) { transpose_item(args.in[7] + (size_t)l * DM * 2 * DFF, DM, 2 * DFF, (bf16_t*)(wl + W_WI1), true, r, lane); continue; } r -= I_WI;
            if (r < I_WI) { transpose_item(args.in[9] + (size_t)l * DM * 2 * DFF, DM, 2 * DFF, (bf16_t*)(wl + W_WI2), true, r, lane); continue; } r -= I_WI;
            if (r < I_WO) { transpose_item(args.in[8] + (size_t)l * DFF * DM, DFF, DM, (bf16_t*)(wl + W_WO1), false, r, lane); continue; } r -= I_WO;
            if (r < I_WO) { transpose_item(args.in[10] + (size_t)l * DFF * DM, DFF, DM, (bf16_t*)(wl + W_WO2), false, r, lane); continue; } r -= I_WO;
            if (r < I_IN) { transpose_item(args.in[11] + (size_t)l * DM * INW, DM, INW, (bf16_t*)(wl + W_WIN), false, r, lane); continue; } r -= I_IN;
            transpose_item(args.in[12] + (size_t)l * DM * DM, DM, DM, (bf16_t*)(wl + W_WOUT), false, r, lane);
        }
        for (int it = gw; it < DEPTH * 72 * 16; it += ngw) {
            const int l = it / (72 * 16), r = it - l * (72 * 16), cc = r >> 4, ks = r & 15;
            LAS float* sv = scr;
            for (int i = lane; i < 5 * 128; i += 64) { const int s = i >> 7, k = ks * 128 + (i & 127); sv[i] = silu_f(s < 4 ? c_in[s * DM + k] : cctx_in[k]); }
            LDS_WAIT(); asm volatile("" ::: "memory");
            const float* wp = w_mod + ((size_t)l * DM + ks * 128) * MODW + cc * 256 + 4 * lane;
            f32x4 a0 = {0, 0, 0, 0}, a1 = a0, a2 = a0, a3 = a0, a4 = a0;
#pragma unroll 8
            for (int k = 0; k < 128; ++k) { const f32x4 w = *(const f32x4*)(wp + (size_t)k * MODW);
                a0 += w * sv[k]; a1 += w * sv[128 + k]; a2 += w * sv[256 + k]; a3 += w * sv[384 + k]; a4 += w * sv[512 + k]; }
            if (ks == 0) { const f32x4 bb = *(const f32x4*)(b_mod + (size_t)l * MODW + cc * 256 + 4 * lane); a0 += bb; a1 += bb; a2 += bb; a3 += bb; a4 += bb; }
            float* mo = MOD + (size_t)l * 5 * MODW + cc * 256 + 4 * lane;
#pragma unroll
            for (int j = 0; j < 4; ++j) { unsafeAtomicAdd(mo + j, a0[j]); unsafeAtomicAdd(mo + MODW + j, a1[j]); unsafeAtomicAdd(mo + 2 * MODW + j, a2[j]); unsafeAtomicAdd(mo + 3 * MODW + j, a3[j]); unsafeAtomicAdd(mo + 4 * MODW + j, a4[j]); }
            LDS_WAIT(); asm volatile("" ::: "memory");
        }
        for (int i = gw * 64 + lane; i < MC * DM / 4; i += ngw * 64) ((f32x4*)XC)[i] = ((const f32x4*)ctx_in)[i];
        { const int gt = gw * 64 + lane; if (gt < 128 * 32) { const int pos = gt >> 5, i = gt & 31; const float f = exp2f(-(float)i * 0.4152410118609203f); float c, s; sincos_small((float)pos * f, c, s); ROPE[2 * gt] = c; ROPE[2 * gt + 1] = s; } }
        SEAM(0);
    }

#pragma unroll LAYER_UNROLL
    for (int l = 0; l < DEPTH; ++l) {
        const int pb = 1 + 11 * l;
        unsigned char* wl = ws + WS_W + (size_t)l * W_LAYER;
        const float* modl = MOD + (size_t)l * 5 * MODW;
        const float* nw = norm_w + (size_t)l * 3 * DM;
        const float* xl_cur = (l == 0) ? x_in : xout;
        const float* xc_cur = XC;
        const bool lastl = (l == DEPTH - 1); const int MPOST = lastl ? ML : MT;

        if (PHON(1) && IN(pb + 0)) { DUPREP(1) { PHASE_IDS(); norm_phase(xl_cur, xc_cur, XC, (l > 0 && rep == 0) ? PART : nullptr, nw, modl, 0, 1, H, MT, gw, ngw, lane); } SEAM(pb + 0); }
        if (PHON(2) && IN(pb + 1)) {
            DUPREP(2) {
            PHASE_IDS();
            pg8::Gemm g{H, (const bf16_t*)(wl + W_WI1), MT, 2 * DFF, DM, DM}; pg8::StaticOrder S; S.init(MT, 2 * DFF, G, bx);
            pg8::EpiSwiglu E{HID};
            pg8::gemm_phase<pg8::EpiSwiglu, pg8::StaticOrder, true, true>(lds, g, S, E);
            }
            SEAM(pb + 1);
        }
        if (PHON(3) && IN(pb + 2)) {
            DUPREP(3) {
            PHASE_IDS();
            pg8::Gemm g{HID, (const bf16_t*)(wl + W_WO1), ML, DM, DFF, DFF}; pg8::StaticOrder S; S.init(ML, DM, G, bx, RESID_WGM);
            pg8::EpiResid E{xl_cur, XC, ISDUMMY(3) ? DUML : xout, XC, modl + 2 * DM, 0.5f};
            pg8::gemm_phase<pg8::EpiResid, pg8::StaticOrder, true, true>(lds, g, S, E);
            if (!ISDUMMY(3)) {
                pg8::Gemm gc{HID + (size_t)ML * DFF, (const bf16_t*)(wl + W_WO1), MC, DM, DFF / 4, DFF}; pg8::CtxSplitOrder SC{bx, (unsigned)(DFF / 4) * 2u};
                pg8::EpiPartial EC{PART, modl + 4 * MODW + 2 * DM, 0.5f, (unsigned)(DFF / 4) * 2u};
                pg8::gemm_phase<pg8::EpiPartial, pg8::CtxSplitOrder, true, true>(lds, gc, SC, EC);
            }
            }
            SEAM(pb + 2);
        }
        if (PHON(4) && IN(pb + 3)) { DUPREP(4) { PHASE_IDS(); norm_phase(xout, XC, XC, rep == 0 ? PART : nullptr, nw + DM, modl, 3, 4, H, MT, gw, ngw, lane); } SEAM(pb + 3); }
        if (PHON(5) && IN(pb + 4)) {
            DUPREP(5) {
            PHASE_IDS();
            pg8::Gemm g{H, (const bf16_t*)(wl + W_WIN), MT, INW, DM, DM}; pg8::StaticOrder S; S.init(MT, INW, G, bx);
            pg8::EpiBf16 E{P, INW};
            pg8::gemm_phase<pg8::EpiBf16, pg8::StaticOrder, true, true>(lds, g, S, E);
            }
            SEAM(pb + 4);
        }
        if (PHON(6) && IN(pb + 5)) { PHASE_IDS(); prep_phase(P, na_gain + (size_t)l * 256, wa_gain + (size_t)l * 256, ROPE, gw * 64 + lane, ngw * 64); SEAM(pb + 5); }
        if (PHON(7) && IN(pb + 6)) {
            DUPREP(7) {
            PHASE_IDS();
            const float* sinkp = wa_sink + l * 8; const float* rpbp = na_rpb + (size_t)l * 4 * 15 * 31;
            constexpr int U_WA = 1024, U_NA = 512;
            const int U_CN = lastl ? 0 : 16, U_CW = lastl ? 0 : 32, U_ATT = U_WA + U_NA + U_CN + U_CW, U_POOL = (MPOST / 256) * 4;
            for (int idx = vcu; idx < U_ATT + U_POOL; idx += G) {
                if (idx < U_WA) { att::attn_unit(P, MIX, sinkp, rpbp, na_gain + (size_t)l * 256, wa_gain + (size_t)l * 256, ROPE, 0, idx >> 8, (idx >> 2) & 63, idx & 3, (LAS char*)lds); }
                else if (idx < U_WA + U_NA) { const int r = idx - U_WA; att::attn_unit(P, MIX, sinkp, rpbp, na_gain + (size_t)l * 256, wa_gain + (size_t)l * 256, ROPE, 1, r >> 7, (r >> 2) & 31, r & 3, (LAS char*)lds); }
                else if (idx < U_WA + U_NA + U_CN) { const int r = idx - U_WA - U_NA; att::attn_unit(P, MIX, sinkp, rpbp, na_gain + (size_t)l * 256, wa_gain + (size_t)l * 256, ROPE, 2, r >> 2, r & 3, 0, (LAS char*)lds); }
                else if (idx < U_ATT) { const int r = idx - U_WA - U_NA - U_CN; att::attn_unit(P, MIX, sinkp, rpbp, na_gain + (size_t)l * 256, wa_gain + (size_t)l * 256, ROPE, 3, r >> 3, r & 7, 0, (LAS char*)lds); }
                else { const int r = idx - U_ATT; __syncthreads(); pool_unit(P, MIX, pool_w + (size_t)l * 4 * 16384, pool_scale + (size_t)l * 512, r >> 2, r & 3, (LAS char*)lds); }
            }
            }
            SEAM(pb + 6);
        }
        if (PHON(8) && IN(pb + 7)) {
            DUPREP(8) {
            PHASE_IDS();
            pg8::Gemm g{MIX, (const bf16_t*)(wl + W_WOUT), ML, DM, DM, DM}; pg8::StaticOrder S; S.init(ML, DM, G, bx, RESID_WGM);
            pg8::EpiResid E{xout, XC, ISDUMMY(8) ? DUML : xout, XC, modl + 5 * DM, 1.0f};
            pg8::gemm_phase<pg8::EpiResid, pg8::StaticOrder, true, true>(lds, g, S, E);
            if (!lastl && !ISDUMMY(8)) {
                pg8::Gemm gc{MIX + (size_t)ML * DM, (const bf16_t*)(wl + W_WOUT), MC, DM, DM / 4, DM}; pg8::CtxSplitOrder SC{bx, (unsigned)(DM / 4) * 2u};
                pg8::EpiPartial EC{PART, modl + 4 * MODW + 5 * DM, 1.0f, (unsigned)(DM / 4) * 2u};
                pg8::gemm_phase<pg8::EpiPartial, pg8::CtxSplitOrder, true, true>(lds, gc, SC, EC);
            }
            }
            SEAM(pb + 7);
        }
        if (PHON(9) && IN(pb + 8)) { DUPREP(9) { PHASE_IDS(); norm_phase(xout, XC, XC, rep == 0 ? PART : nullptr, nw + 2 * DM, modl, 6, 7, H, MPOST, gw, ngw, lane); } SEAM(pb + 8); }
        if (PHON(10) && IN(pb + 9)) {
            DUPREP(10) {
            PHASE_IDS();
            pg8::Gemm g{H, (const bf16_t*)(wl + W_WI2), MPOST, 2 * DFF, DM, DM}; pg8::StaticOrder S; S.init(MPOST, 2 * DFF, G, bx);
            pg8::EpiSwiglu E{HID};
            pg8::gemm_phase<pg8::EpiSwiglu, pg8::StaticOrder, true, true>(lds, g, S, E);
            }
            SEAM(pb + 9);
        }
        if (PHON(11) && IN(pb + 10)) {
            DUPREP(11) {
            PHASE_IDS();
            pg8::Gemm g{HID, (const bf16_t*)(wl + W_WO2), ML, DM, DFF, DFF}; pg8::StaticOrder S; S.init(ML, DM, G, bx, RESID_WGM);
            pg8::EpiResid E{xout, XC, ISDUMMY(11) ? DUML : xout, XC, modl + 8 * DM, 0.5f};
            pg8::gemm_phase<pg8::EpiResid, pg8::StaticOrder, true, true>(lds, g, S, E);
            if (!lastl && !ISDUMMY(11)) {
                pg8::Gemm gc{HID + (size_t)ML * DFF, (const bf16_t*)(wl + W_WO2), MC, DM, DFF / 4, DFF}; pg8::CtxSplitOrder SC{bx, (unsigned)(DFF / 4) * 2u};
                pg8::EpiPartial EC{PART, modl + 4 * MODW + 8 * DM, 0.5f, (unsigned)(DFF / 4) * 2u};
                pg8::gemm_phase<pg8::EpiPartial, pg8::CtxSplitOrder, true, true>(lds, gc, SC, EC);
            }
            }
            if (l + 1 < DEPTH) SEAM(pb + 10);
        }
    }
#undef IN
#undef SEAM
#undef GRID_BAR
}

template <int PHMASK> static bool prep_kernel(int& per_cu) {
    if (hipFuncSetAttribute((const void*)fwd_kernel<PHMASK>, hipFuncAttributeMaxDynamicSharedMemorySize, LDS_BYTES) != hipSuccess) { fprintf(stderr, "kernel_launch: hipFuncSetAttribute failed (mask %x)\n", PHMASK); return false; }
    if (hipOccupancyMaxActiveBlocksPerMultiprocessor(&per_cu, (const void*)fwd_kernel<PHMASK>, 512, LDS_BYTES) != hipSuccess || per_cu < 1) fprintf(stderr, "kernel_launch: occupancy query reports %d (mask %x)\n", per_cu, PHMASK);
    (void)hipGetLastError();
    return true;
}
template <int PHMASK> static void launch_k(int grid, const Args& a, hipStream_t stream) { hipLaunchKernelGGL(fwd_kernel<PHMASK>, dim3(grid), dim3(512), LDS_BYTES, stream, a); }
extern "C" void kernel_launch(void* const* d_in, const int* in_sizes, int n_in, void* d_out, int out_size, void* d_ws, size_t ws_size, hipStream_t stream) {
    static int grid = 0;
    if (grid == 0) {
        if (n_in != 19 || in_sizes[0] != ML * DM || out_size != ML * DM || ws_size < WS_END + (DUPMASK ? 264 * MiB : 0)) {
            fprintf(stderr, "kernel_launch: shape mismatch: n_in %d in0 %d out %d ws %zu (need %zu)\n", n_in, n_in > 0 ? in_sizes[0] : -1, out_size, ws_size, (size_t)WS_END); grid = -1; return; }
        int dev = 0, cus = 0, per_cu = 0; bool ok = true;
        if (hipGetDevice(&dev) != hipSuccess || hipDeviceGetAttribute(&cus, hipDeviceAttributeMultiprocessorCount, dev) != hipSuccess) { grid = -1; return; }
#if MK_SINGLE
        ok = prep_kernel<0xFFF>(per_cu);
#else
        ok = prep_kernel<1>(per_cu) && prep_kernel<2>(per_cu) && prep_kernel<4>(per_cu) && prep_kernel<8>(per_cu) && prep_kernel<16>(per_cu) && prep_kernel<32>(per_cu) && prep_kernel<64>(per_cu)
          && prep_kernel<128>(per_cu) && prep_kernel<256>(per_cu) && prep_kernel<512>(per_cu) && prep_kernel<1024>(per_cu) && prep_kernel<2048>(per_cu);
#endif
        if (!ok) { grid = -1; return; }
        grid = cus;
    }
    if (grid < 0) return;
    if (hipMemsetAsync((char*)d_ws + WS_CTL, 0, CTL_ZERO_BYTES, stream) != hipSuccess) { fprintf(stderr, "kernel_launch: memset failed\n"); return; }
    Args a{};
    for (int i = 0; i < 19; ++i) a.in[i] = (const float*)d_in[i];
    a.out = (float*)d_out; a.ws = (unsigned char*)d_ws;
#if MK_SINGLE
    a.ph_lo = 0; a.ph_hi = NPH;
    launch_k<0xFFF>(grid, a, stream);
#else
    for (int ph = 0; ph < NPH; ++ph) { a.ph_lo = ph; a.ph_hi = ph + 1;
        const int bit = (ph == 0) ? 0 : 1 + (ph - 1) % 11;
        switch (bit) { case 0: launch_k<1>(grid, a, stream); break; case 1: launch_k<2>(grid, a, stream); break; case 2: launch_k<4>(grid, a, stream); break; case 3: launch_k<8>(grid, a, stream); break;
            case 4: launch_k<16>(grid, a, stream); break; case 5: launch_k<32>(grid, a, stream); break; case 6: launch_k<64>(grid, a, stream); break; case 7: launch_k<128>(grid, a, stream); break;
            case 8: launch_k<256>(grid, a, stream); break; case 9: launch_k<512>(grid, a, stream); break; case 10: launch_k<1024>(grid, a, stream); break; default: launch_k<2048>(grid, a, stream); break; } }
#endif
    const hipError_t le = hipPeekAtLastError();
    if (le != hipSuccess) fprintf(stderr, "kernel_launch: launch failed: %s\n", hipGetErrorName(le));
}
```
